# Optimizing an MI355X kernel written in HIP

```python
import math
import jax, jax.numpy as jnp
from jax import lax
import numpy as np

D_MODEL = 1024
BATCH = 4
SEQ = 4096
DEPTH = 2

N_MIXERS = 2
FNET_GROUPS = 8
FNET_GROUP_DIM = D_MODEL // FNET_GROUPS
DIFF_HEADS = 8
DK = D_MODEL // (2 * DIFF_HEADS)
DV = 2 * DK
QK_WIDTH = DIFF_HEADS * 2 * DK
V_WIDTH = DIFF_HEADS * DV
Q_BLOCK = 128
ALIBI_MAX_BIAS = 8.0
D_FF = 2816
CONV_WIDTH = 3
LN_EPS = 1e-5
ALPHA = (2.0 * DEPTH) ** 0.25
BETA = (8.0 * DEPTH) ** -0.25

kernel_name = "hybrid_fnet_diffattn_encoder"


def layer_norm(x, g=None, b=None, eps=LN_EPS):
    xf = x.astype(jnp.float32)
    mu = jnp.mean(xf, axis=-1, keepdims=True)
    xc = xf - mu
    var = jnp.mean(jnp.square(xc), axis=-1, keepdims=True)
    y = xc * lax.rsqrt(var + eps)
    if g is not None:
        y = y * g.astype(jnp.float32) + b.astype(jnp.float32)
    return y.astype(x.dtype)


def modulate(x, shift, scale):
    return layer_norm(x) * (1 + scale[:, None, :]) + shift[:, None, :]


def fourier_mixer(h, w_out):
    B, S, D = h.shape
    hg = h.astype(jnp.float32).reshape(B, S, FNET_GROUPS, FNET_GROUP_DIM)
    f = jnp.fft.fft2(hg, axes=(1, 3), norm="ortho").real
    return f.reshape(B, S, D).astype(h.dtype) @ w_out


def diff_attention(h, w_in, lq1, lk1, lq2, lk2, subln_g, w_out, layer_idx):
    B, S, _ = h.shape
    qkv = h @ w_in
    q = qkv[..., :QK_WIDTH].astype(jnp.float32).reshape(B, S, DIFF_HEADS, 2, DK)
    k = qkv[..., QK_WIDTH:2 * QK_WIDTH].astype(jnp.float32).reshape(B, S, DIFF_HEADS, 2, DK)
    v = qkv[..., 2 * QK_WIDTH:].astype(jnp.float32).reshape(B, S, DIFF_HEADS, DV)

    lam_init = 0.8 - 0.6 * math.exp(-0.3 * layer_idx)
    lam = (jnp.exp(jnp.sum(lq1.astype(jnp.float32) * lk1.astype(jnp.float32)))
           - jnp.exp(jnp.sum(lq2.astype(jnp.float32) * lk2.astype(jnp.float32)))
           + lam_init)
    slopes = jnp.exp2(-ALIBI_MAX_BIAS * jnp.arange(1, DIFF_HEADS + 1, dtype=jnp.float32) / DIFF_HEADS)

    nb = S // Q_BLOCK
    qb = q.reshape(B, nb, Q_BLOCK, DIFF_HEADS, 2, DK).transpose(1, 0, 2, 3, 4, 5) * (DK ** -0.5)
    pos_k = jnp.arange(S, dtype=jnp.float32)

    def one_block(args):
        q_blk, blk = args
        pos_q = (blk * Q_BLOCK + jnp.arange(Q_BLOCK)).astype(jnp.float32)
        dist = jnp.abs(pos_q[:, None] - pos_k[None, :])
        bias = -slopes[:, None, None] * dist
        s = jnp.einsum('bqhcd,bkhcd->bhcqk', q_blk, k) + bias[None, :, None]
        p = jax.nn.softmax(s, axis=-1)
        a = p[:, :, 0] - lam * p[:, :, 1]
        return jnp.einsum('bhqk,bkhd->bqhd', a, v)

    o = lax.map(one_block, (qb, jnp.arange(nb)))
    o = o.transpose(1, 0, 2, 3, 4).reshape(B, S, DIFF_HEADS, DV)
    o = o * lax.rsqrt(jnp.mean(jnp.square(o), axis=-1, keepdims=True) + LN_EPS)
    o = o * subln_g.astype(jnp.float32) * (1.0 - lam_init)
    return o.reshape(B, S, V_WIDTH).astype(h.dtype) @ w_out


def conv_gated_ffn(h, w_up, conv_w, conv_b, w_down):
    u = h @ w_up
    up = jnp.pad(u, ((0, 0), (1, 1), (0, 0)))
    u = up[:, :-2] * conv_w[0] + up[:, 1:-1] * conv_w[1] + up[:, 2:] * conv_w[2] + conv_b
    val, gate = u[..., :D_FF], u[..., D_FF:]
    return (jax.nn.gelu(gate, approximate=False) * val) @ w_down


def setup_inputs(seed: int = 0) -> dict:
    key = jax.random.key(seed)
    keys = iter(jax.random.split(key, 64))

    def nrm(shape, scale):
        return jax.random.normal(next(keys), shape, jnp.float32) * scale

    def gain(n):
        return 1.0 + nrm((n,), 0.02)

    d = {}
    d["x"] = nrm((BATCH, SEQ, D_MODEL), 1.0)
    d["c"] = nrm((BATCH, D_MODEL), 1.0)

    def ada(prefix):
        d[prefix + "ada_w"] = nrm((D_MODEL, 6 * D_MODEL), 0.5 * D_MODEL ** -0.5)
        d[prefix + "ada_b"] = nrm((6 * D_MODEL,), 0.01)

    def ln(name):
        d[name + "_g"] = gain(D_MODEL)
        d[name + "_b"] = nrm((D_MODEL,), 0.01)

    def ffn(prefix):
        d[prefix + "ffn_w_up"] = nrm((D_MODEL, 2 * D_FF), BETA * D_MODEL ** -0.5)
        d[prefix + "ffn_conv_w"] = nrm((CONV_WIDTH, 2 * D_FF), CONV_WIDTH ** -0.5)
        d[prefix + "ffn_conv_b"] = nrm((2 * D_FF,), 0.01)
        d[prefix + "ffn_w_down"] = nrm((D_FF, D_MODEL), BETA * D_FF ** -0.5)

    ada("l0_")
    d["l0_fnet_w_out"] = nrm((D_MODEL, D_MODEL), BETA * D_MODEL ** -0.5)
    ln("l0_ln_mix")
    ffn("l0_")
    ln("l0_ln_ffn")

    ada("l1_")
    w_qk = nrm((D_MODEL, 2 * QK_WIDTH), D_MODEL ** -0.5)
    w_v = nrm((D_MODEL, V_WIDTH), BETA * D_MODEL ** -0.5)
    d["l1_attn_w_in"] = jnp.concatenate([w_qk, w_v], axis=1)
    d["l1_attn_lambda_q1"] = nrm((DK,), 0.1)
    d["l1_attn_lambda_k1"] = nrm((DK,), 0.1)
    d["l1_attn_lambda_q2"] = nrm((DK,), 0.1)
    d["l1_attn_lambda_k2"] = nrm((DK,), 0.1)
    d["l1_attn_subln_g"] = gain(DV)
    d["l1_attn_w_out"] = nrm((V_WIDTH, D_MODEL), BETA * V_WIDTH ** -0.5)
    ln("l1_ln_mix")
    ffn("l1_")
    ln("l1_ln_ffn")
    return d


def reference(x, c,
              l0_ada_w, l0_ada_b, l0_fnet_w_out, l0_ln_mix_g, l0_ln_mix_b,
              l0_ffn_w_up, l0_ffn_conv_w, l0_ffn_conv_b, l0_ffn_w_down, l0_ln_ffn_g, l0_ln_ffn_b,
              l1_ada_w, l1_ada_b, l1_attn_w_in, l1_attn_lambda_q1, l1_attn_lambda_k1,
              l1_attn_lambda_q2, l1_attn_lambda_k2, l1_attn_subln_g, l1_attn_w_out,
              l1_ln_mix_g, l1_ln_mix_b,
              l1_ffn_w_up, l1_ffn_conv_w, l1_ffn_conv_b, l1_ffn_w_down, l1_ln_ffn_g, l1_ln_ffn_b):
    ada_w = (l0_ada_w, l1_ada_w)
    ada_b = (l0_ada_b, l1_ada_b)
    ln_mix = ((l0_ln_mix_g, l0_ln_mix_b), (l1_ln_mix_g, l1_ln_mix_b))
    ln_ffn = ((l0_ln_ffn_g, l0_ln_ffn_b), (l1_ln_ffn_g, l1_ln_ffn_b))
    ffn_p = ((l0_ffn_w_up, l0_ffn_conv_w, l0_ffn_conv_b, l0_ffn_w_down),
             (l1_ffn_w_up, l1_ffn_conv_w, l1_ffn_conv_b, l1_ffn_w_down))
    mixer_a_p = ((l0_fnet_w_out,),)
    mixer_b_p = ((l1_attn_w_in, l1_attn_lambda_q1, l1_attn_lambda_k1, l1_attn_lambda_q2,
                  l1_attn_lambda_k2, l1_attn_subln_g, l1_attn_w_out),)

    c_act = jax.nn.silu(c)
    for i in range(DEPTH):
        mod = c_act @ ada_w[i] + ada_b[i]
        sh1, sc1, g1, sh2, sc2, g2 = jnp.split(mod, 6, axis=-1)

        h = modulate(x, sh1, sc1)
        if i % N_MIXERS == 0:
            y = fourier_mixer(h, *mixer_a_p[i // N_MIXERS])
        else:
            y = diff_attention(h, *mixer_b_p[i // N_MIXERS], layer_idx=i)
        x = layer_norm(ALPHA * x + g1[:, None, :] * y, *ln_mix[i])

        h = modulate(x, sh2, sc2)
        y = conv_gated_ffn(h, *ffn_p[i])
        x = layer_norm(ALPHA * x + g2[:, None, :] * y, *ln_ffn[i])
    return x
```

```cpp
#include <hip/hip_runtime.h>
#include <hip/hip_cooperative_groups.h>
#include <cstdio>
#include <cstdint>
namespace cg = cooperative_groups;

#ifndef MK_ONE_LAUNCH
#define MK_ONE_LAUNCH 1
#endif

#define LAS __attribute__((address_space(3)))
typedef unsigned short bf16_t;
typedef short bf16x8 __attribute__((ext_vector_type(8)));
typedef float f32x4 __attribute__((ext_vector_type(4)));
typedef float f32x2 __attribute__((ext_vector_type(2)));
typedef float f32x16 __attribute__((ext_vector_type(16)));
typedef unsigned u32x4 __attribute__((ext_vector_type(4)));
typedef unsigned u32x2 __attribute__((ext_vector_type(2)));

constexpr int NB = 4, SEQ = 4096, DM = 1024, MTOK = NB * SEQ, DFF = 2816, NUP = 2 * DFF, NH = 8;
constexpr float LN_EPS = 1e-5f;
constexpr float ALPHA = 1.4142135623730951f;
constexpr float LAM_INIT = 0.35550906759096926f;
constexpr float C2 = 0.125f * 1.4426950408889634f;
constexpr float LOG2E = 1.4426950408889634f;

constexpr size_t MiB = 1u << 20;
constexpr size_t WS_MODPART = 0;
constexpr size_t WS_MOD = 2 * MiB;
constexpr size_t WS_SCAL = 2 * MiB + 512 * 1024;
constexpr size_t WS_BAR = 2 * MiB + 768 * 1024;
constexpr size_t WS_STATS = 2 * MiB + 896 * 1024;
constexpr size_t WS_UEDGE = 3 * MiB;
constexpr size_t WS_XT = 9 * MiB;
constexpr size_t WS_H = 73 * MiB;
constexpr size_t WS_CS = 105 * MiB;
constexpr size_t WS_UT = 137 * MiB;
constexpr size_t WS_ACT = 105 * MiB;
constexpr size_t WS_QK = 105 * MiB;
constexpr size_t WS_VT = 169 * MiB;
constexpr size_t WS_WCS = 211 * MiB;
constexpr size_t WS_UP0 = 215 * MiB;
constexpr size_t WS_DN0 = 226 * MiB;
constexpr size_t WS_WIN = WS_DN0 + 5632 * 1024;
constexpr size_t WS_WO = WS_WIN + 6 * MiB;
constexpr size_t WS_UP1 = WS_WO + 2 * MiB;
constexpr size_t WS_DN1 = WS_UP1 + 11 * MiB;
constexpr size_t WS_END = WS_DN1 + 5632 * 1024;
static_assert(WS_END <= 256 * MiB, "workspace map");

constexpr int LDS_BYTES = 147456;
constexpr int XCH_OFF = 131072;

__device__ __forceinline__ unsigned f2bf(float f) { unsigned u = __builtin_bit_cast(unsigned, f); return (u + 0x7fffu + ((u >> 16) & 1u)) >> 16; }
__device__ __forceinline__ unsigned pk2(float lo, float hi) { return f2bf(lo) | (f2bf(hi) << 16); }
__device__ __forceinline__ unsigned cvt_pk_bf16(float lo, float hi) { unsigned r; asm volatile("v_cvt_pk_bf16_f32 %0, %1, %2" : "=v"(r) : "v"(lo), "v"(hi)); return r; }
__device__ __forceinline__ float bf2f(short s) { return __builtin_bit_cast(float, ((unsigned)(unsigned short)s) << 16); }
__device__ __forceinline__ float wave_sum(float v) {
#pragma unroll
    for (int o = 1; o < 64; o <<= 1) v += __shfl_xor(v, o);
    return v;
}
__device__ __forceinline__ float max3f(float a, float b, float c) { float r; asm("v_max3_f32 %0, %1, %2, %3" : "=v"(r) : "v"(a), "v"(b), "v"(c)); return r; }
__device__ __forceinline__ float half_swap_max(float m) { auto rr = __builtin_amdgcn_permlane32_swap(__float_as_uint(m), __float_as_uint(m), false, false); return fmaxf(__uint_as_float(rr[0]), __uint_as_float(rr[1])); }
__device__ __forceinline__ float half_swap_sum(float m) { auto rr = __builtin_amdgcn_permlane32_swap(__float_as_uint(m), __float_as_uint(m), false, false); return __uint_as_float(rr[0]) + __uint_as_float(rr[1]); }

__device__ __forceinline__ f32x2 gelu_pk(f32x2 v) {
    const f32x2 av = __builtin_elementwise_abs(v), d = av * 0.2316418882f + 1.0f;
    f32x2 t; t.x = __builtin_amdgcn_rcpf(d.x); t.y = __builtin_amdgcn_rcpf(d.y);
    f32x2 q = t * 0.5307027145f + (-0.7265760135f); q = q * t + 0.7107068705f; q = q * t + (-0.142248368f); q = q * t + 0.127414796f; q = q * t;
    const f32x2 s = (v * v) * (-0.72134752044f);
    f32x2 e; e.x = __builtin_amdgcn_exp2f(s.x); e.y = __builtin_amdgcn_exp2f(s.y);
    const f32x2 m = v * (q * e), r = v - m;
    f32x2 o; o.x = v.x < 0.f ? m.x : r.x; o.y = v.y < 0.f ? m.y : r.y; return o;
}
__device__ __forceinline__ float gelu1(float x) { f32x2 r = gelu_pk((f32x2){x, x}); return r.x; }

constexpr int BM = 256, BK = 64, HALF = 128, HTB = HALF * BK * 2, NXCD = 8, WGM = 8;
__device__ __forceinline__ int lds_byte(int r, int c) { const int st = (r >> 4) * 2 + (c >> 5), rr = r & 15, cc = c & 31, ob = rr * 64 + cc * 2; return st * 1024 + (ob ^ (((ob >> 9) & 1) << 5)); }
__device__ __forceinline__ void stage_rc(int b, int& R, int& C) { const int st = b / 1024, sb = b % 1024, swz = sb ^ (((sb >> 9) & 1) << 5); R = (st >> 1) * 16 + swz / 64; C = (st & 1) * 32 + (swz % 64) / 2; }
__device__ __forceinline__ int perm32(int rho) { const int n = rho >> 4, i = rho & 15; return 8 * (i >> 2) + 4 * n + (i & 3); }

struct Unit { int pm, pn, am, bn; };
struct Gemm { const bf16_t* A; const bf16_t* Bt; int lda, ldb, K; };

struct Order {
    int nM, nN, nwg, G, c, mode;
    __device__ void init(int nM_, int nN_, int G_, int c_, int mode_) { nM = nM_; nN = nN_; nwg = nM * nN; G = G_; c = c_; mode = mode_; }
    __device__ bool next(int i, Unit& u) const {
        const long L = (long)i * G + c; if (L >= nwg) return false;
        int wgid = (int)L; { const int q = nwg / NXCD, r = nwg % NXCD, xcd = wgid % NXCD, off = wgid / NXCD; wgid = (xcd < r ? xcd * (q + 1) : r * (q + 1) + (xcd - r) * q) + off; }
        const int nig = WGM * nN, gid = wgid / nig, fm = gid * WGM, gsz = (nM - fm) < WGM ? (nM - fm) : WGM;
        u.pm = fm + ((wgid % nig) % gsz); u.pn = (wgid % nig) / gsz;
        if (mode == 1) { u.am = u.pm & 15; u.bn = (u.pm >> 4) * 4 + u.pn; }
        else if (mode == 2) { u.am = 8 + u.pm; u.bn = u.pn; }
        else { u.am = u.pm; u.bn = u.pn; }
        return true;
    }
};
struct OrderU {
    int G, c;
    __device__ bool next(int i, Unit& u) const {
        const long L = (long)i * G + c; if (L >= 256) return false;
        const int l = (int)L, pnq = l & 7, pmq = (l >> 3) & 3, part = (l >> 5) & 1, b = l >> 6;
        u.am = part * 4 + pmq; u.bn = b * 16 + part * 8 + pnq; u.pm = u.am; u.pn = u.bn; return true;
    }
};

struct EpiQK {
    static constexpr bool PERM = true;
    bf16_t* O; unsigned* kmax2;
    __device__ __forceinline__ void operator()(f32x4 (&acc)[2][2][4][2], const Unit& u, int wid, int lane) const {
        const int wr = wid >> 2, wc = wid & 3, fr = lane & 15, fq = lane >> 4;
        if (u.pn >= 4) {
            float mx0 = 0.f, mx1 = 0.f;
#pragma unroll
            for (int ai = 0; ai < 2; ++ai)
#pragma unroll
                for (int m = 0; m < 4; ++m)
#pragma unroll
                    for (int bj = 0; bj < 2; ++bj) { const f32x4 v0 = acc[ai][bj][m][0], v1 = acc[ai][bj][m][1];
                        float q = (v0[0] * v0[0] + v0[1] * v0[1]) + (v0[2] * v0[2] + v0[3] * v0[3]) + (v1[0] * v1[0] + v1[1] * v1[1]) + (v1[2] * v1[2] + v1[3] * v1[3]);
                        q += __shfl_xor(q, 16); q += __shfl_xor(q, 32);
                        if (bj == 0) mx0 = fmaxf(mx0, q); else mx1 = fmaxf(mx1, q); }
#pragma unroll
            for (int o = 1; o < 16; o <<= 1) { mx0 = fmaxf(mx0, __shfl_xor(mx0, o)); mx1 = fmaxf(mx1, __shfl_xor(mx1, o)); }
            if (lane == 0) { const int b = u.pm >> 4, hd = 2 * (u.pn - 4);
                atomicMax(kmax2 + ((b * 8 + hd) * 2 + (wc >> 1)) * 2 + (wc & 1), __float_as_uint(mx0));
                atomicMax(kmax2 + ((b * 8 + hd + 1) * 2 + (wc >> 1)) * 2 + (wc & 1), __float_as_uint(mx1)); }
        }
        const float sc = (u.pn < 4) ? C2 : 1.f;
        const int row0 = u.pm * BM + wr * 64 + fr, col0 = u.pn * BM + wc * 32 + 8 * fq;
#pragma unroll
        for (int ai = 0; ai < 2; ++ai)
#pragma unroll
            for (int m = 0; m < 4; ++m) { bf16_t* rowp = O + (size_t)(row0 + ai * HALF + m * 16) * 2048 + col0;
#pragma unroll
                for (int bj = 0; bj < 2; ++bj) { const f32x4 v0 = acc[ai][bj][m][0] * sc, v1 = acc[ai][bj][m][1] * sc;
                    u32x4 w; w.x = cvt_pk_bf16(v0[0], v0[1]); w.y = cvt_pk_bf16(v0[2], v0[3]); w.z = cvt_pk_bf16(v1[0], v1[1]); w.w = cvt_pk_bf16(v1[2], v1[3]);
                    *(u32x4*)(rowp + bj * HALF) = w; } }
    }
};
struct EpiUt {
    static constexpr bool PERM = true;
    bf16_t* O;
    __device__ __forceinline__ void operator()(f32x4 (&acc)[2][2][4][2], const Unit& u, int wid, int lane) const {
        const int wr = wid >> 2, wc = wid & 3, fr = lane & 15, fq = lane >> 4;
        const int b = u.bn >> 4, kk0 = (u.bn & 15) * 256 + wc * 32 + 8 * fq;
        const int c0 = (u.am & 3) * 256 + wr * 64 + fr;
#pragma unroll
        for (int ai = 0; ai < 2; ++ai)
#pragma unroll
            for (int m = 0; m < 4; ++m) { bf16_t* rowp = O + ((size_t)(b * 1024 + c0 + ai * HALF + m * 16)) * 4096 + kk0;
#pragma unroll
                for (int bj = 0; bj < 2; ++bj) { const f32x4 v0 = acc[ai][bj][m][0], v1 = acc[ai][bj][m][1];
                    u32x4 w; w.x = cvt_pk_bf16(v0[0], v0[1]); w.y = cvt_pk_bf16(v0[2], v0[3]); w.z = cvt_pk_bf16(v1[0], v1[1]); w.w = cvt_pk_bf16(v1[2], v1[3]);
                    if (kk0 + bj * HALF == 2048) {
                        bf16_t* p = rowp + bj * HALF;
                        p[1] = (bf16_t)(w.x >> 16); *(unsigned*)(p + 2) = w.y; *(unsigned*)(p + 4) = w.z; *(unsigned*)(p + 6) = w.w;
                    } else *(u32x4*)(rowp + bj * HALF) = w; } }
    }
};
struct EpiVT {
    static constexpr bool PERM = true;
    bf16_t* O;
    __device__ __forceinline__ void operator()(f32x4 (&acc)[2][2][4][2], const Unit& u, int wid, int lane) const {
        const int wr = wid >> 2, wc = wid & 3, fr = lane & 15, fq = lane >> 4;
        const int b = u.bn >> 4, n0 = (u.bn & 15) * 256 + wc * 32 + 8 * fq;
        const int odd = (n0 >> 3) & 1, base16 = n0 & ~15;
        const int d0 = u.pm * 256 + wr * 64 + fr;
#pragma unroll
        for (int ai = 0; ai < 2; ++ai)
#pragma unroll
            for (int m = 0; m < 4; ++m) { bf16_t* rowp = O + ((size_t)(b * 1024 + d0 + ai * HALF + m * 16)) * 4096 + base16;
#pragma unroll
                for (int bj = 0; bj < 2; ++bj) { const f32x4 v0 = acc[ai][bj][m][0], v1 = acc[ai][bj][m][1];
                    u32x2 w0, w1; w0.x = cvt_pk_bf16(v0[0], v0[1]); w0.y = cvt_pk_bf16(v0[2], v0[3]); w1.x = cvt_pk_bf16(v1[0], v1[1]); w1.y = cvt_pk_bf16(v1[2], v1[3]);
                    *(u32x2*)(rowp + bj * HALF + (odd ? 4 : 0)) = w0; *(u32x2*)(rowp + bj * HALF + (odd ? 12 : 8)) = w1; } }
    }
};
struct EpiResid {
    static constexpr bool PERM = false;
    const float* X; float* T; const float* gate;
    __device__ __forceinline__ void operator()(f32x4 (&acc)[2][2][4][2], const Unit& u, int wid, int lane) const {
        const int wr = wid >> 2, wc = wid & 3, fr = lane & 15, fq = lane >> 4;
        const int b = u.pm >> 4, row0 = u.pm * BM + wr * 64 + fr, col0 = u.pn * BM + wc * 32 + 4 * fq;
#pragma unroll
        for (int bj = 0; bj < 2; ++bj)
#pragma unroll
            for (int n = 0; n < 2; ++n) { const int col = col0 + bj * HALF + n * 16; const f32x4 gv = *(const f32x4*)(gate + b * 6144 + col);
#pragma unroll
                for (int ai = 0; ai < 2; ++ai) {
#pragma unroll
                    for (int m = 0; m < 4; ++m) { const size_t off = (size_t)(row0 + ai * HALF + m * 16) * DM + col;
                        const f32x4 xv = *(const f32x4*)(X + off); *(f32x4*)(T + off) = xv * ALPHA + gv * acc[ai][bj][m][n]; }
                    asm volatile("" ::: "memory"); } }
    }
};
struct EpiResidLN {
    static constexpr bool PERM = false;
    const float* X; float* T; const float* gate; const float* stats; const float* lg; const float* lb;
    __device__ __forceinline__ void operator()(f32x4 (&acc)[2][2][4][2], const Unit& u, int wid, int lane) const {
        const int wr = wid >> 2, wc = wid & 3, fr = lane & 15, fq = lane >> 4;
        const int b = u.pm >> 4, row0 = u.pm * BM + wr * 64 + fr, col0 = u.pn * BM + wc * 32 + 4 * fq;
        f32x2 st[2][4];
#pragma unroll
        for (int ai = 0; ai < 2; ++ai)
#pragma unroll
            for (int m = 0; m < 4; ++m) st[ai][m] = *(const f32x2*)(stats + 2 * (size_t)(row0 + ai * HALF + m * 16));
#pragma unroll
        for (int bj = 0; bj < 2; ++bj)
#pragma unroll
            for (int n = 0; n < 2; ++n) { const int col = col0 + bj * HALF + n * 16; const f32x4 gv = *(const f32x4*)(gate + b * 6144 + col);
                const f32x4 lgv = *(const f32x4*)(lg + col), lbv = *(const f32x4*)(lb + col);
#pragma unroll
                for (int ai = 0; ai < 2; ++ai) {
#pragma unroll
                    for (int m = 0; m < 4; ++m) { const size_t off = (size_t)(row0 + ai * HALF + m * 16) * DM + col;
                        const f32x4 xv = *(const f32x4*)(X + off); const f32x4 x1 = (xv - st[ai][m].x) * st[ai][m].y * lgv + lbv;
                        *(f32x4*)(T + off) = x1 * ALPHA + gv * acc[ai][bj][m][n]; }
                    asm volatile("" ::: "memory"); } }
    }
};
__device__ __forceinline__ float dpp_up(float prev_lane0_src, float cur) {
    return __builtin_bit_cast(float, __builtin_amdgcn_update_dpp(__builtin_bit_cast(int, prev_lane0_src), __builtin_bit_cast(int, cur), 0x111, 0xf, 0xf, false)); }
__device__ __forceinline__ float dpp_dn(float next_lane15_src, float cur) {
    return __builtin_bit_cast(float, __builtin_amdgcn_update_dpp(__builtin_bit_cast(int, next_lane15_src), __builtin_bit_cast(int, cur), 0x101, 0xf, 0xf, false)); }
__device__ __forceinline__ float dpp_ror1(float v) { return __builtin_bit_cast(float, __builtin_amdgcn_update_dpp(0, __builtin_bit_cast(int, v), 0x121, 0xf, 0xf, false)); }
__device__ __forceinline__ float dpp_ror15(float v) { return __builtin_bit_cast(float, __builtin_amdgcn_update_dpp(0, __builtin_bit_cast(int, v), 0x12F, 0xf, 0xf, false)); }

struct EpiFFN {
    static constexpr bool PERM = true;
    bf16_t* act; float* uedge; const float* cw; const float* cb; LAS float* xch;
    __device__ __forceinline__ void operator()(f32x4 (&acc)[2][2][4][2], const Unit& u, int wid, int lane) const {
        const int wr = wid >> 2, wc = wid & 3, fr = lane & 15, fq = lane >> 4;
        LAS f32x4* X = (LAS f32x4*)xch;
#pragma unroll
        for (int ai = 0; ai < 2; ++ai)
#pragma unroll
            for (int bj = 0; bj < 2; ++bj)
#pragma unroll
                for (int n = 0; n < 2; ++n) {
                    if (fr == 0)  X[(((((wid * 2 + ai) * 2 + 0) * 2 + bj) * 2 + n) * 4) + fq] = acc[ai][bj][0][n];
                    if (fr == 15) X[(((((wid * 2 + ai) * 2 + 1) * 2 + bj) * 2 + n) * 4) + fq] = acc[ai][bj][3][n];
                }
        {
            const int colb = u.pn * 256 + wc * 32 + 8 * fq;
            if (wr == 0 && fr < 2) {
#pragma unroll
                for (int bj = 0; bj < 2; ++bj)
#pragma unroll
                    for (int n = 0; n < 2; ++n) *(f32x4*)(uedge + (size_t)(u.pm * 4 + fr) * NUP + colb + bj * HALF + 4 * n) = acc[0][bj][0][n];
            }
            if (wr == 1 && fr >= 14) {
#pragma unroll
                for (int bj = 0; bj < 2; ++bj)
#pragma unroll
                    for (int n = 0; n < 2; ++n) *(f32x4*)(uedge + (size_t)(u.pm * 4 + 2 + (fr - 14)) * NUP + colb + bj * HALF + 4 * n) = acc[1][bj][3][n];
            }
        }
        asm volatile("s_waitcnt lgkmcnt(0)\n\ts_barrier" ::: "memory");
        const int ch0 = u.pn * 128 + wc * 32 + 8 * fq;
#pragma unroll
        for (int n = 0; n < 2; ++n) {
            const int ch = ch0 + 4 * n;
            const f32x4 wv0 = *(const f32x4*)(cw + ch), wv1 = *(const f32x4*)(cw + NUP + ch), wv2 = *(const f32x4*)(cw + 2 * NUP + ch), bv = *(const f32x4*)(cb + ch);
            const f32x4 wg0 = *(const f32x4*)(cw + DFF + ch), wg1 = *(const f32x4*)(cw + NUP + DFF + ch), wg2 = *(const f32x4*)(cw + 2 * NUP + DFF + ch), bg = *(const f32x4*)(cb + DFF + ch);
#pragma unroll
            for (int ai = 0; ai < 2; ++ai) {
                const bool has_prev = !(wr == 0 && ai == 0), has_next = !(wr == 1 && ai == 1);
                const int pw = (wr == 1) ? wid - 4 : wid + 4, pai = (wr == 1) ? ai : 0;
                const int nw = (wr == 0) ? wid + 4 : wid - 4, nai = (wr == 0) ? ai : 1;
                f32x4 pv = (f32x4){0.f, 0.f, 0.f, 0.f}, pg = pv, nv = pv, ng = pv;
                if (has_prev) { pv = X[(((((pw * 2 + pai) * 2 + 1) * 2 + 0) * 2 + n) * 4) + fq]; pg = X[(((((pw * 2 + pai) * 2 + 1) * 2 + 1) * 2 + n) * 4) + fq]; }
                if (has_next) { nv = X[(((((nw * 2 + nai) * 2 + 0) * 2 + 0) * 2 + n) * 4) + fq]; ng = X[(((((nw * 2 + nai) * 2 + 0) * 2 + 1) * 2 + n) * 4) + fq]; }
#pragma unroll
                for (int m = 0; m < 4; ++m) {
                    const f32x4 cv = acc[ai][0][m][n], cg = acc[ai][1][m][n];
                    f32x4 uv, ug, dv, dg;
#pragma unroll
                    for (int e = 0; e < 4; ++e) {
                        const float xv = (m == 0) ? pv[e] : dpp_ror1(pv[e]), xg = (m == 0) ? pg[e] : dpp_ror1(pg[e]);
                        uv[e] = dpp_up(xv, cv[e]); ug[e] = dpp_up(xg, cg[e]);
                        const float yv = (m == 3) ? nv[e] : dpp_ror15(acc[ai][0][m + 1 > 3 ? 3 : m + 1][n][e]), yg = (m == 3) ? ng[e] : dpp_ror15(acc[ai][1][m + 1 > 3 ? 3 : m + 1][n][e]);
                        dv[e] = dpp_dn(yv, cv[e]); dg[e] = dpp_dn(yg, cg[e]);
                    }
                    const f32x4 val = wv0 * uv + wv1 * cv + wv2 * dv + bv;
                    const f32x4 gat = wg0 * ug + wg1 * cg + wg2 * dg + bg;
                    const f32x2 g01 = gelu_pk((f32x2){gat[0], gat[1]}), g23 = gelu_pk((f32x2){gat[2], gat[3]});
                    f32x4 r; r.x = __uint_as_float(cvt_pk_bf16(g01.x * val[0], g01.y * val[1])); r.y = __uint_as_float(cvt_pk_bf16(g23.x * val[2], g23.y * val[3])); r.z = 0.f; r.w = 0.f;
                    acc[ai][0][m][n] = r;
                    pv = cv; pg = cg;
                }
            }
        }
        const int row0 = u.pm * BM + wr * 64 + fr;
#pragma unroll
        for (int ai = 0; ai < 2; ++ai)
#pragma unroll
            for (int m = 0; m < 4; ++m) {
                u32x4 w; w.x = __float_as_uint(acc[ai][0][m][0].x); w.y = __float_as_uint(acc[ai][0][m][0].y); w.z = __float_as_uint(acc[ai][0][m][1].x); w.w = __float_as_uint(acc[ai][0][m][1].y);
                *(u32x4*)(act + (size_t)(row0 + ai * HALF + m * 16) * DFF + ch0) = w;
            }
    }
};

template <class Epi, class Sched>
__device__ __forceinline__ void gemm_phase(LAS unsigned char* lds, const Gemm g, const Sched& S, const Epi& E) {
    const int tid = threadIdx.x, wid = __builtin_amdgcn_readfirstlane(tid >> 6), lane = tid & 63, wr = wid >> 2, wc = wid & 3, fr = lane & 15, fq = lane >> 4;
    const int K = g.K, nt = K / BK;
    unsigned voffA[2], voffB[2];
#pragma unroll
    for (int i = 0; i < 2; ++i) { int R, C; stage_rc(tid * 16 + i * 8192, R, C); const int Rb = Epi::PERM ? ((R & ~31) + perm32(R & 31)) : R;
        voffA[i] = (unsigned)(R * g.lda + C) * 2u; voffB[i] = (unsigned)(Rb * g.ldb + C) * 2u; }
    const size_t kstep = (size_t)(BK * 2);
    const size_t hA = (size_t)HALF * g.lda * 2, hB = (size_t)HALF * g.ldb * 2, tA = 2 * hA, tB = 2 * hB;
    const unsigned ldsw = (unsigned)wid * 1024u;
    const int aoff = lds_byte(wr * 64 + fr, fq * 8), boff = lds_byte(wc * 32 + fr, fq * 8);
#define PG8_SA(b, h) (((b) * 2 + (h)) * HTB)
#define PG8_SB(b, h) ((4 + (b) * 2 + (h)) * HTB)
#define PG8_STAGE(bufoff, gbase, voff) do { _Pragma("unroll") for (int _i = 0; _i < 2; ++_i) \
        __builtin_amdgcn_global_load_lds((const unsigned*)((const char*)(gbase) + (voff)[_i]), (LAS unsigned*)(lds + (bufoff) + ldsw + _i * 8192), 16, 0, 0); } while (0)
#define PG8_LDA(dst, b, h) do { _Pragma("unroll") for (int m = 0; m < 4; ++m) _Pragma("unroll") for (int k = 0; k < 2; ++k) dst[m][k] = *(const LAS bf16x8*)(lds + PG8_SA(b, h) + aoff + m * 2048 + k * 1024); } while (0)
#define PG8_LDB(dst, b, h) do { _Pragma("unroll") for (int n = 0; n < 2; ++n) _Pragma("unroll") for (int k = 0; k < 2; ++k) dst[n][k] = *(const LAS bf16x8*)(lds + PG8_SB(b, h) + boff + n * 2048 + k * 1024); } while (0)
#define PG8_MMA(ai, bj, At, Bt) do { __builtin_amdgcn_s_setprio(1); _Pragma("unroll") for (int m = 0; m < 4; ++m) _Pragma("unroll") for (int n = 0; n < 2; ++n) _Pragma("unroll") for (int k = 0; k < 2; ++k) \
        acc[ai][bj][m][n] = __builtin_amdgcn_mfma_f32_16x16x32_bf16(Bt[n][k], At[m][k], acc[ai][bj][m][n], 0, 0, 0); __builtin_amdgcn_s_setprio(0); } while (0)
#define PG8_WAIT_V(n) asm volatile("s_waitcnt vmcnt(" #n ")" ::: "memory")
#define PG8_WAIT_L(n) asm volatile("s_waitcnt lgkmcnt(" #n ")" ::: "memory")
#define PG8_BAR __builtin_amdgcn_s_barrier()
#define PG8_SCHED __builtin_amdgcn_sched_barrier(0)
    Unit cur, nxt; int ui = 0;
    if (!S.next(0, cur)) return;
    f32x4 acc[2][2][4][2];
#pragma unroll
    for (int a = 0; a < 2; ++a)
#pragma unroll
        for (int b = 0; b < 2; ++b)
#pragma unroll
            for (int m = 0; m < 4; ++m)
#pragma unroll
                for (int n = 0; n < 2; ++n) acc[a][b][m][n] = (f32x4){0.f, 0.f, 0.f, 0.f};
    bf16x8 At[4][2], B0[2][2], B1[2][2];
    const char* cA = (const char*)g.A + (size_t)cur.am * tA; const char* cB = (const char*)g.Bt + (size_t)cur.bn * tB;
    PG8_STAGE(PG8_SB(0, 0), cB, voffB); PG8_STAGE(PG8_SB(0, 1), cB + hB, voffB); PG8_STAGE(PG8_SA(0, 0), cA, voffA); PG8_STAGE(PG8_SA(0, 1), cA + hA, voffA);
    if (wr == 1) PG8_BAR;
    PG8_WAIT_V(2); PG8_BAR;
    PG8_STAGE(PG8_SB(1, 0), cB + kstep, voffB); PG8_STAGE(PG8_SA(1, 0), cA + kstep, voffA); PG8_STAGE(PG8_SB(1, 1), cB + hB + kstep, voffB);
    PG8_WAIT_V(6); PG8_BAR;
    for (;;) {
        const bool has_next = S.next(ui + 1, nxt);
        const char* nA = has_next ? (const char*)g.A + (size_t)nxt.am * tA : cA; const char* nB = has_next ? (const char*)g.Bt + (size_t)nxt.bn * tB : cB;
        for (int t = 0; t < nt; t += 2) {
            const bool last = (t == nt - 2);
            const char* a1 = cA + (size_t)(t + 1) * kstep;
            const char* a2 = last ? nA : cA + (size_t)(t + 2) * kstep; const char* b2 = last ? nB : cB + (size_t)(t + 2) * kstep;
            const char* a3 = a2 + kstep; const char* b3 = b2 + kstep;
            PG8_LDB(B0, 0, 0); PG8_LDB(B1, 0, 1); PG8_SCHED; PG8_LDA(At, 0, 0); PG8_STAGE(PG8_SA(1, 1), a1 + hA, voffA);
            PG8_WAIT_V(8); PG8_WAIT_L(0); PG8_BAR; PG8_MMA(0, 0, At, B0); PG8_MMA(0, 1, At, B1); PG8_BAR; PG8_SCHED;
            PG8_LDA(At, 0, 1); PG8_STAGE(PG8_SB(0, 0), b2, voffB); PG8_STAGE(PG8_SB(0, 1), b2 + hB, voffB); PG8_STAGE(PG8_SA(0, 0), a2, voffA);
            PG8_WAIT_V(8); PG8_WAIT_L(0); PG8_BAR; PG8_MMA(1, 0, At, B0); PG8_MMA(1, 1, At, B1); PG8_BAR; PG8_SCHED;
            PG8_LDB(B0, 1, 0); PG8_LDB(B1, 1, 1); PG8_SCHED; PG8_LDA(At, 1, 0); PG8_STAGE(PG8_SA(0, 1), a2 + hA, voffA);
            PG8_WAIT_V(8); PG8_WAIT_L(0); PG8_BAR; PG8_MMA(0, 0, At, B0); PG8_MMA(0, 1, At, B1); PG8_BAR; PG8_SCHED;
            PG8_LDA(At, 1, 1); PG8_STAGE(PG8_SB(1, 0), b3, voffB); PG8_STAGE(PG8_SB(1, 1), b3 + hB, voffB); PG8_STAGE(PG8_SA(1, 0), a3, voffA);
            PG8_WAIT_V(8); PG8_WAIT_L(0); PG8_BAR; PG8_MMA(1, 0, At, B0); PG8_MMA(1, 1, At, B1); PG8_BAR; PG8_SCHED;
        }
        if (wr == 0) PG8_BAR;
        E(acc, cur, wid, lane);
        if (!has_next) break;
#pragma unroll
        for (int a = 0; a < 2; ++a)
#pragma unroll
            for (int b = 0; b < 2; ++b)
#pragma unroll
                for (int m = 0; m < 4; ++m)
#pragma unroll
                    for (int n = 0; n < 2; ++n) acc[a][b][m][n] = (f32x4){0.f, 0.f, 0.f, 0.f};
        cur = nxt; cA = nA; cB = nB; ++ui;
        if (wr == 1) PG8_BAR;
    }
    PG8_WAIT_V(0);
    PG8_BAR;
#undef PG8_SA
#undef PG8_SB
#undef PG8_STAGE
#undef PG8_LDA
#undef PG8_LDB
#undef PG8_MMA
#undef PG8_WAIT_V
#undef PG8_WAIT_L
#undef PG8_BAR
#undef PG8_SCHED
}

template <int MODE> __device__ __forceinline__ int wrow(int n) {
    if (MODE == 0) return n;
    return n < DFF ? (n / 128) * 256 + (n % 128) : ((n - DFF) / 128) * 256 + 128 + ((n - DFF) % 128);
}
template <int MODE> __device__ __forceinline__ void transpose_item(const float* W, int K, int N, bf16_t* WT, LAS float* scr, int item, int lane) {
    const int nblk = N / 32, kb = item / nblk, nb = item % nblk, k0 = 64 * kb, n0 = 32 * nb;
#pragma unroll
    for (int i = 0; i < 32; ++i) { const int kk = 2 * i + (lane >> 5); scr[kk * 33 + (lane & 31)] = W[(size_t)(k0 + kk) * N + n0 + (lane & 31)]; }
    asm volatile("s_waitcnt lgkmcnt(0)" ::: "memory");
    const int c = lane & 7;
#pragma unroll
    for (int j = 0; j < 4; ++j) { const int n = (lane >> 3) + 8 * j; const LAS float* s = scr + (8 * c) * 33 + n;
        u32x4 o; o.x = pk2(s[0 * 33], s[1 * 33]); o.y = pk2(s[2 * 33], s[3 * 33]); o.z = pk2(s[4 * 33], s[5 * 33]); o.w = pk2(s[6 * 33], s[7 * 33]);
        *(u32x4*)(WT + (size_t)wrow<MODE>(n0 + n) * K + k0 + 8 * c) = o; }
    asm volatile("s_waitcnt lgkmcnt(0)" ::: "memory");
}

__device__ __forceinline__ void row_load(const float* p, int lane, f32x4 (&v)[4]) {
#pragma unroll
    for (int j = 0; j < 4; ++j) v[j] = *(const f32x4*)(p + 256 * j + 4 * lane);
}
__device__ __forceinline__ void row_stats(const f32x4 (&v)[4], float& mean, float& rstd) {
    float s = 0.f;
#pragma unroll
    for (int j = 0; j < 4; ++j) s += (v[j].x + v[j].y) + (v[j].z + v[j].w);
    mean = wave_sum(s) * (1.f / DM); float s2 = 0.f;
#pragma unroll
    for (int j = 0; j < 4; ++j) { const f32x4 d = v[j] - mean; s2 += (d.x * d.x + d.y * d.y) + (d.z * d.z + d.w * d.w); }
    rstd = 1.f / sqrtf(wave_sum(s2) * (1.f / DM) + LN_EPS);
}
__device__ __forceinline__ void row_store_bf16(bf16_t* p, int lane, const f32x4 (&v)[4]) {
#pragma unroll
    for (int j = 0; j < 4; ++j) { u32x2 w; w.x = pk2(v[j].x, v[j].y); w.y = pk2(v[j].z, v[j].w); *(u32x2*)(p + 256 * j + 4 * lane) = w; }
}

__device__ __forceinline__ int crow(int r, int hi) { return (r & 3) + 8 * (r >> 2) + 4 * hi; }

__device__ __forceinline__ void attn_phase(LAS unsigned char* lds, const bf16_t* __restrict__ QK, const bf16_t* __restrict__ VT, bf16_t* __restrict__ O,
                                           unsigned* ctr, const float* __restrict__ subln_g, const float* lamp) {
    const unsigned* kmax2 = ctr + 16;
    const int tid = threadIdx.x, lane = tid & 63, wid = __builtin_amdgcn_readfirstlane(tid >> 6), r32 = lane & 31, hi = lane >> 5;
    const int sub = wid >> 2, qw = wid & 3;
    LAS unsigned* uslot = (LAS unsigned*)(lds + 98304);
    const float lam = *lamp;
    int kog[2], vog[2]; unsigned kld[2], vld[2];
#pragma unroll
    for (int i = 0; i < 2; ++i) {
        const int p = wid * 2 + i;
        const int kv = 4 * p + (lane >> 4), cc = (lane & 15) ^ (kv & 15);
        kog[i] = kv * 2048 + cc * 8; kld[i] = (unsigned)p * 1024u;
        const int d = 8 * p + (lane >> 3), j = (lane & 7) ^ ((d >> 1) & 7);
        vog[i] = d * 4096 + j * 8; vld[i] = 16384u + (unsigned)p * 1024u;
    }
    int kaddr[4], vaddr[4];
    { const int kb = (sub * 8 + hi) ^ (r32 & 15), vb = hi ^ ((r32 >> 1) & 7);
#pragma unroll
      for (int q = 0; q < 4; ++q) { kaddr[q] = r32 * 256 + ((kb ^ (2 * q)) * 16); vaddr[q] = 16384 + r32 * 128 + ((vb ^ (2 * q)) * 16); } }
#define ATT_DMA(t_, st_) do { _Pragma("unroll") for (int i_ = 0; i_ < 2; ++i_) { \
        __builtin_amdgcn_global_load_lds((const unsigned*)(Kg + (size_t)(t_) * 64 * 2048 + kog[i_]), (LAS unsigned*)(lds + (st_) + kld[i_]), 16, 0, 0); \
        __builtin_amdgcn_global_load_lds((const unsigned*)(Vg + (t_) * 64 + vog[i_]), (LAS unsigned*)(lds + (st_) + vld[i_]), 16, 0, 0); } } while (0)
    for (;;) {
        __syncthreads();
        if (tid == 0) *uslot = atomicAdd(ctr, 1u);
        __syncthreads();
        const unsigned un = *uslot;
        if (un >= 1024u) break;
        const int h = 7 - (int)(un >> 7), rr = (int)(un & 127u), b = rr >> 5, qb = rr & 31;
        const float slope2 = __builtin_amdgcn_exp2f(-(float)(h + 1)) * LOG2E;
        const int qpos = qb * 128 + qw * 32 + r32;
        const bf16_t* Qrow = QK + (size_t)(b * SEQ + qpos) * 2048 + h * 128 + sub * 64;
        const bf16_t* Kg = QK + (size_t)b * SEQ * 2048 + 1024 + h * 128;
        const bf16_t* Vg = VT + ((size_t)(b * 1024 + h * 128)) * 4096;
        bf16x8 qr[4];
#pragma unroll
        for (int d0 = 0; d0 < 4; ++d0) qr[d0] = *(const bf16x8*)(Qrow + d0 * 16 + hi * 8);
        float mhat; int tlo, thi;
        { float sd = 0.f, qn = 0.f;
#pragma unroll
          for (int d0 = 0; d0 < 4; ++d0) { const bf16x8 kd = *(const bf16x8*)(Qrow + 1024 + d0 * 16 + hi * 8);
#pragma unroll
              for (int e = 0; e < 8; ++e) { const float qv = bf2f(qr[d0][e]); sd += qv * bf2f(kd[e]); qn += qv * qv; } }
          mhat = half_swap_sum(sd); qn = half_swap_sum(qn);
          const unsigned* kp = kmax2 + ((b * 8 + h) * 2 + sub) * 2;
          const float km2 = (__uint_as_float(kp[0]) + __uint_as_float(kp[1])) * 1.02f;
          float wb = sqrtf(qn * km2) * 1.01f + 0.5f - mhat;
#pragma unroll
          for (int o_ = 1; o_ < 64; o_ <<= 1) wb = fmaxf(wb, __shfl_xor(wb, o_));
          LAS float* wmx = (LAS float*)(lds + 98304 + 64);
          if (lane == 0) wmx[wid] = wb;
          __syncthreads();
          float bm = wmx[0];
#pragma unroll
          for (int w_ = 1; w_ < 8; ++w_) bm = fmaxf(bm, wmx[w_]);
          const float dmax = (140.f + bm) / slope2;
          const float flo = ((float)(qb * 128) - dmax) * (1.f / 64.f), fhi = ((float)(qb * 128 + 127) + dmax) * (1.f / 64.f);
          tlo = flo <= 0.f ? 0 : (int)flo; thi = fhi >= 63.f ? 63 : (int)fhi;
          if (!(bm == bm)) { tlo = 0; thi = 63; }
        }
        ATT_DMA(tlo, 0); if (tlo + 1 <= thi) ATT_DMA(tlo + 1, 32768);
        f32x16 o[4];
#pragma unroll
        for (int db = 0; db < 4; ++db)
#pragma unroll
            for (int r = 0; r < 16; ++r) o[db][r] = 0.f;
        float l_reg = 0.f;
        asm volatile("s_waitcnt vmcnt(0)\n\ts_barrier" ::: "memory");
        int st = 0, st2 = 65536;
        float crs[16];
#pragma unroll
        for (int r = 0; r < 16; ++r) crs[r] = slope2 * (float)((r & 3) + 8 * (r >> 2));
        const int qlo = qb * 128 + qw * 32;
        for (int t = tlo; t <= thi; ++t) {
            if (t + 2 <= thi) ATT_DMA(t + 2, st2);
            {
                const LAS unsigned char* Sb = lds + st;
                bf16x8 kf[8];
#pragma unroll
                for (int d0 = 0; d0 < 4; ++d0) { kf[2 * d0] = *(const LAS bf16x8*)(Sb + kaddr[d0]); kf[2 * d0 + 1] = *(const LAS bf16x8*)(Sb + kaddr[d0] + 8192); }
                __builtin_amdgcn_sched_barrier(0);
                const int kv0 = t * 64;
                const float dq = (float)(qpos - kv0 - 4 * hi);
                f32x16 p0, p1;
                if (kv0 + 63 < qlo || kv0 > qlo + 31) {
                    const float sg = (kv0 + 63 < qlo) ? 1.f : -1.f;
                    const float b0 = -sg * slope2 * dq - mhat, b1 = b0 + sg * slope2 * 32.f;
#pragma unroll
                    for (int r = 0; r < 16; ++r) { p0[r] = __builtin_fmaf(sg, crs[r], b0); p1[r] = __builtin_fmaf(sg, crs[r], b1); }
                } else {
#pragma unroll
                    for (int r = 0; r < 16; ++r) { const float cr = (float)((r & 3) + 8 * (r >> 2));
                        p0[r] = __builtin_fmaf(-slope2, __builtin_fabsf(dq - cr), -mhat); p1[r] = __builtin_fmaf(-slope2, __builtin_fabsf(dq - cr - 32.f), -mhat); }
                }
                __builtin_amdgcn_sched_barrier(0);
#pragma unroll
                for (int d0 = 0; d0 < 4; ++d0) {
                    p0 = __builtin_amdgcn_mfma_f32_32x32x16_bf16(kf[2 * d0], qr[d0], p0, 0, 0, 0);
                    p1 = __builtin_amdgcn_mfma_f32_32x32x16_bf16(kf[2 * d0 + 1], qr[d0], p1, 0, 0, 0);
                }
                bf16x8 vf[8];
#pragma unroll
                for (int g = 0; g < 4; ++g) { vf[g] = *(const LAS bf16x8*)(Sb + vaddr[g]); vf[4 + g] = *(const LAS bf16x8*)(Sb + vaddr[g] + 4096); }
                asm volatile("s_nop 15\n\ts_nop 7" : "+v"(p0), "+v"(p1));
                float rm, rm2;
                rm = max3f(p0[0], p0[1], p1[0]); rm2 = max3f(p0[2], p0[3], p1[1]); rm = max3f(rm, p1[2], p1[3]);
#pragma unroll
                for (int r = 4; r < 16; r += 4) { rm = max3f(rm, p0[r], p0[r + 1]); rm2 = max3f(rm2, p0[r + 2], p0[r + 3]); rm = max3f(rm, p1[r], p1[r + 1]); rm2 = max3f(rm2, p1[r + 2], p1[r + 3]); }
                rm = half_swap_max(fmaxf(rm, rm2));
                if (__any(rm > 8.f)) {
                    const float dl = fmaxf(rm, 0.f); mhat += dl;
                    const float f = __builtin_amdgcn_exp2f(-dl); l_reg *= f;
#pragma unroll
                    for (int r = 0; r < 16; ++r) { p0[r] -= dl; p1[r] -= dl; }
#pragma unroll
                    for (int db = 0; db < 4; ++db)
#pragma unroll
                        for (int r = 0; r < 16; ++r) o[db][r] *= f;
                    rm -= dl;
                }
                if (!__all(rm < -140.f)) {
                    float sacc = 0.f, sacc2 = 0.f;
#pragma unroll
                    for (int r = 0; r < 16; ++r) { p0[r] = __builtin_amdgcn_exp2f(p0[r]); p1[r] = __builtin_amdgcn_exp2f(p1[r]); sacc += p0[r]; sacc2 += p1[r]; }
                    l_reg += sacc + sacc2;
                    u32x4 w0, w1, w2, w3;
                    w0.x = cvt_pk_bf16(p0[0], p0[1]); w0.y = cvt_pk_bf16(p0[2], p0[3]); w0.z = cvt_pk_bf16(p0[4], p0[5]); w0.w = cvt_pk_bf16(p0[6], p0[7]);
                    w1.x = cvt_pk_bf16(p0[8], p0[9]); w1.y = cvt_pk_bf16(p0[10], p0[11]); w1.z = cvt_pk_bf16(p0[12], p0[13]); w1.w = cvt_pk_bf16(p0[14], p0[15]);
                    w2.x = cvt_pk_bf16(p1[0], p1[1]); w2.y = cvt_pk_bf16(p1[2], p1[3]); w2.z = cvt_pk_bf16(p1[4], p1[5]); w2.w = cvt_pk_bf16(p1[6], p1[7]);
                    w3.x = cvt_pk_bf16(p1[8], p1[9]); w3.y = cvt_pk_bf16(p1[10], p1[11]); w3.z = cvt_pk_bf16(p1[12], p1[13]); w3.w = cvt_pk_bf16(p1[14], p1[15]);
                    const bf16x8 pb0 = __builtin_bit_cast(bf16x8, w0), pb1 = __builtin_bit_cast(bf16x8, w1), pb2 = __builtin_bit_cast(bf16x8, w2), pb3 = __builtin_bit_cast(bf16x8, w3);
                    __builtin_amdgcn_sched_barrier(0);
                    bf16x8 vg[8];
#pragma unroll
                    for (int g = 0; g < 4; ++g) { vg[g] = *(const LAS bf16x8*)(Sb + vaddr[g] + 8192); vg[4 + g] = *(const LAS bf16x8*)(Sb + vaddr[g] + 12288); }
                    o[0] = __builtin_amdgcn_mfma_f32_32x32x16_bf16(vf[0], pb0, o[0], 0, 0, 0); o[1] = __builtin_amdgcn_mfma_f32_32x32x16_bf16(vf[4], pb0, o[1], 0, 0, 0);
                    o[0] = __builtin_amdgcn_mfma_f32_32x32x16_bf16(vf[1], pb1, o[0], 0, 0, 0); o[1] = __builtin_amdgcn_mfma_f32_32x32x16_bf16(vf[5], pb1, o[1], 0, 0, 0);
                    o[0] = __builtin_amdgcn_mfma_f32_32x32x16_bf16(vf[2], pb2, o[0], 0, 0, 0); o[1] = __builtin_amdgcn_mfma_f32_32x32x16_bf16(vf[6], pb2, o[1], 0, 0, 0);
                    o[0] = __builtin_amdgcn_mfma_f32_32x32x16_bf16(vf[3], pb3, o[0], 0, 0, 0); o[1] = __builtin_amdgcn_mfma_f32_32x32x16_bf16(vf[7], pb3, o[1], 0, 0, 0);
                    __builtin_amdgcn_sched_barrier(0);
                    o[2] = __builtin_amdgcn_mfma_f32_32x32x16_bf16(vg[0], pb0, o[2], 0, 0, 0); o[3] = __builtin_amdgcn_mfma_f32_32x32x16_bf16(vg[4], pb0, o[3], 0, 0, 0);
                    o[2] = __builtin_amdgcn_mfma_f32_32x32x16_bf16(vg[1], pb1, o[2], 0, 0, 0); o[3] = __builtin_amdgcn_mfma_f32_32x32x16_bf16(vg[5], pb1, o[3], 0, 0, 0);
                    o[2] = __builtin_amdgcn_mfma_f32_32x32x16_bf16(vg[2], pb2, o[2], 0, 0, 0); o[3] = __builtin_amdgcn_mfma_f32_32x32x16_bf16(vg[6], pb2, o[3], 0, 0, 0);
                    o[2] = __builtin_amdgcn_mfma_f32_32x32x16_bf16(vg[3], pb3, o[2], 0, 0, 0); o[3] = __builtin_amdgcn_mfma_f32_32x32x16_bf16(vg[7], pb3, o[3], 0, 0, 0);
                }
            }
            if (t + 2 <= thi) asm volatile("s_waitcnt vmcnt(4) lgkmcnt(0)\n\ts_barrier" ::: "memory");
            else asm volatile("s_waitcnt vmcnt(0) lgkmcnt(0)\n\ts_barrier" ::: "memory");
            st2 = st; st = (st == 65536) ? 0 : st + 32768;
        }
        const float inv = 1.f / half_swap_sum(l_reg);
        LAS float* XO = (LAS float*)lds;
        if (sub == 1) {
#pragma unroll
            for (int db = 0; db < 4; ++db)
#pragma unroll
                for (int r = 0; r < 16; ++r) XO[((qw * 64 + db * 16 + r) * 64) + lane] = o[db][r] * inv;
        }
        __syncthreads();
        if (sub == 0) {
            float ss = 0.f;
#pragma unroll
            for (int db = 0; db < 4; ++db)
#pragma unroll
                for (int r = 0; r < 16; ++r) { const float v = o[db][r] * inv - lam * XO[((qw * 64 + db * 16 + r) * 64) + lane]; o[db][r] = v; ss += v * v; }
            ss = half_swap_sum(ss);
            const float rs = (1.f / sqrtf(ss * (1.f / 128.f) + LN_EPS)) * (1.f - LAM_INIT);
            bf16_t* Orow = O + (size_t)(b * SEQ + qpos) * DM + h * 128;
#pragma unroll
            for (int db = 0; db < 4; ++db)
#pragma unroll
                for (int rq = 0; rq < 4; ++rq) {
                    const int d = db * 32 + 8 * rq + 4 * hi;
                    const f32x4 gv = *(const f32x4*)(subln_g + d);
                    u32x2 w; w.x = cvt_pk_bf16(o[db][4 * rq + 0] * rs * gv.x, o[db][4 * rq + 1] * rs * gv.y); w.y = cvt_pk_bf16(o[db][4 * rq + 2] * rs * gv.z, o[db][4 * rq + 3] * rs * gv.w);
                    *(u32x2*)(Orow + d) = w;
                }
        }
    }
}

#define XB_TMO      128
#define XB_XCNT(j)  (256  + 64 * (j))
#define XB_XSUB(j)  (1280 + 64 * (j))
#define XB_XGEN(j)  (2304 + 64 * (j))
#define XB_TOP      3328
#define XB_TOPGEN   3392
#define XCD_BAR_WORDS 3456
#define XB_SPIN_CAP (1u << 18)
__device__ __forceinline__ unsigned xb_ld(unsigned* p)              { return __hip_atomic_load(p, __ATOMIC_RELAXED, __HIP_MEMORY_SCOPE_AGENT); }
__device__ __forceinline__ unsigned xb_add(unsigned* p, unsigned v) { return __hip_atomic_fetch_add(p, v, __ATOMIC_RELAXED, __HIP_MEMORY_SCOPE_AGENT); }
__device__ __forceinline__ unsigned xb_xcc_id() { return (unsigned)__builtin_amdgcn_s_getreg((3 << 11) | 20) & 0xFu; }
#define XB_SPIN(cond, bar) do { unsigned _sp = 0; while (cond) { __builtin_amdgcn_s_sleep(1); \
    if ((++_sp & 255u) == 0u) { if (xb_ld(&(bar)[XB_TMO])) break; if (_sp > XB_SPIN_CAP) { atomicAdd(&(bar)[XB_TMO], 1u); break; } } } } while (0)
struct XcdBarrier { unsigned* bar; unsigned x; volatile LAS unsigned* st; };
__device__ __forceinline__ XcdBarrier xcd_barrier_post(unsigned* bar, volatile LAS unsigned* st) {
    XcdBarrier b; b.bar = bar; b.x = xb_xcc_id(); b.st = st;
    if (threadIdx.x == 0) (void)xb_add(&bar[XB_XCNT(b.x)], 1u);
    return b;
}
__device__ __forceinline__ void xcd_barrier_complete(unsigned* bar, unsigned x, unsigned& nloc, unsigned& nx) {
    const unsigned G = gridDim.x * gridDim.y * gridDim.z;
    unsigned sum, cnt, mine, sp = 0u;
    for (;;) {
        sum = 0u; cnt = 0u; mine = 0u;
#pragma unroll
        for (unsigned j = 0; j < 16; ++j) { const unsigned c = xb_ld(&bar[XB_XCNT(j)]); sum += c; cnt += (c > 0u) ? 1u : 0u; mine = (j == x) ? c : mine; }
        if (sum == G) break;
        __builtin_amdgcn_s_sleep(1);
        if ((++sp & 255u) == 0u) { if (xb_ld(&bar[XB_TMO])) break; if (sp > XB_SPIN_CAP) { atomicAdd(&bar[XB_TMO], 1u); break; } }
    }
    nloc = mine > 0u ? mine : 1u; nx = cnt > 0u ? cnt : 1u;
}
__device__ __forceinline__ void xcd_barrier(const XcdBarrier& b) {
    asm volatile("s_waitcnt vmcnt(0)" ::: "memory");
    __syncthreads();
    if (threadIdx.x == 0) {
        unsigned* bar = b.bar;
        __builtin_amdgcn_s_waitcnt(0);
        unsigned nloc = b.st[0], nx = b.st[1];
        if (nloc == 0u) { xcd_barrier_complete(bar, b.x, nloc, nx); b.st[0] = nloc; b.st[1] = nx; }
        const unsigned old = xb_add(&bar[XB_XSUB(b.x)], 1u);
        const unsigned gen = old / nloc;
        if (old + 1u == (gen + 1u) * nloc) {
            __builtin_amdgcn_fence(__ATOMIC_RELEASE, "agent");
            asm volatile("s_waitcnt vmcnt(0)" ::: "memory");
            const unsigned og = xb_add(&bar[XB_TOP], 1u);
            const unsigned tg = og / nx;
            if (og + 1u == (tg + 1u) * nx) xb_add(&bar[XB_TOPGEN], 1u);
            else XB_SPIN(xb_ld(&bar[XB_TOPGEN]) == tg, bar);
            __builtin_amdgcn_fence(__ATOMIC_ACQUIRE, "agent");
            xb_add(&bar[XB_XGEN(b.x)], 1u);
            asm volatile("s_waitcnt vmcnt(0)" ::: "memory");
        } else {
            XB_SPIN(xb_ld(&bar[XB_XGEN(b.x)]) == gen, bar);
            __builtin_amdgcn_fence(__ATOMIC_ACQUIRE, "agent");
            asm volatile("s_waitcnt vmcnt(0)" ::: "memory");
        }
    }
    __syncthreads();
}

struct Args { const float* in[30]; float* out; unsigned char* ws; int ph_lo, ph_hi; };
constexpr int N_PHASES = 17;

__global__ void __launch_bounds__(512, 2) mk_fwd(Args a) {
    extern __shared__ __attribute__((aligned(16))) unsigned char lds_raw[];
    LAS unsigned char* lds = (LAS unsigned char*)lds_raw;
    cg::grid_group grid = cg::this_grid();
    const int tid = threadIdx.x, lane = tid & 63, wid = __builtin_amdgcn_readfirstlane(tid >> 6);
    const int G = gridDim.x, gw = blockIdx.x * 8 + wid, NGW = G * 8;
    const int lo = a.ph_lo, hi = a.ph_hi;
    unsigned char* ws = a.ws;
    float* modpart = (float*)(ws + WS_MODPART); float* mod = (float*)(ws + WS_MOD);
    unsigned* ctr = (unsigned*)(ws + WS_SCAL); float* lamp = (float*)(ws + WS_SCAL + 4);
    float* rstats = (float*)(ws + WS_STATS);
    float* uedge = (float*)(ws + WS_UEDGE); float* xt = (float*)(ws + WS_XT);
    bf16_t* hbuf = (bf16_t*)(ws + WS_H); bf16_t* Cs = (bf16_t*)(ws + WS_CS); bf16_t* Ut = (bf16_t*)(ws + WS_UT);
    bf16_t* act = (bf16_t*)(ws + WS_ACT); bf16_t* QKb = (bf16_t*)(ws + WS_QK); bf16_t* VTb = (bf16_t*)(ws + WS_VT);
    bf16_t* Wcs = (bf16_t*)(ws + WS_WCS); bf16_t* Wup0 = (bf16_t*)(ws + WS_UP0); bf16_t* Wdn0 = (bf16_t*)(ws + WS_DN0);
    bf16_t* Win = (bf16_t*)(ws + WS_WIN); bf16_t* Wo = (bf16_t*)(ws + WS_WO); bf16_t* Wup1 = (bf16_t*)(ws + WS_UP1); bf16_t* Wdn1 = (bf16_t*)(ws + WS_DN1);
#define IN(k) (lo <= (k) && (k) < hi)
#define SEAM(k) do { if (IN(k) && IN((k) + 1)) { xcd_barrier(xbar); } } while (0)
    { volatile LAS unsigned* st_ = (volatile LAS unsigned*)(lds + XCH_OFF + 8192); if (tid < 2) st_[tid] = 0u; }
    __syncthreads();
    if (a.ph_hi > 1000) grid.sync();
    XcdBarrier xbar = xcd_barrier_post((unsigned*)(ws + WS_BAR), (volatile LAS unsigned*)(lds + XCH_OFF + 8192));

    if (IN(0)) {
        LAS float* csilu = (LAS float*)lds;
        LAS float* wtile = (LAS float*)(lds + 16384);
        LAS float* scr = (LAS float*)(lds + 34816) + wid * 2112;
        const float* cvec = a.in[1];
        for (int i = tid; i < 4096; i += 512) { const float cv = cvec[i]; csilu[i] = cv / (1.f + __expf(-cv)); }
        __syncthreads();
        for (int it = gw; it < 1536; it += NGW) {
            const int l = it / 768, r = it % 768, nch = r >> 3, kc = r & 7;
            const float* W = (l ? a.in[13] : a.in[2]) + (size_t)(kc * 128) * 6144 + nch * 64 + lane;
            float a0 = 0.f, a1 = 0.f, a2 = 0.f, a3 = 0.f;
#pragma unroll 16
            for (int k = 0; k < 128; ++k) { const float w = W[(size_t)k * 6144]; const int kk = kc * 128 + k;
                a0 += csilu[kk] * w; a1 += csilu[1024 + kk] * w; a2 += csilu[2048 + kk] * w; a3 += csilu[3072 + kk] * w; }
            float* mp = modpart + (size_t)((kc * 2 + l) * 4) * 6144 + nch * 64 + lane;
            mp[0] = a0; mp[6144] = a1; mp[2 * 6144] = a2; mp[3 * 6144] = a3;
        }
        for (int it = gw; it < 10496; it += NGW) {
            int r = it;
            if (r < 2816) { transpose_item<1>(a.in[7], DM, NUP, Wup0, scr, r, lane); continue; } r -= 2816;
            if (r < 1408) { transpose_item<0>(a.in[10], DFF, DM, Wdn0, scr, r, lane); continue; } r -= 1408;
            if (r < 1536) { transpose_item<0>(a.in[15], DM, 3072, Win, scr, r, lane); continue; } r -= 1536;
            if (r < 512) { transpose_item<0>(a.in[21], DM, DM, Wo, scr, r, lane); continue; } r -= 512;
            if (r < 2816) { transpose_item<1>(a.in[24], DM, NUP, Wup1, scr, r, lane); continue; } r -= 2816;
            transpose_item<0>(a.in[27], DFF, DM, Wdn1, scr, r, lane);
        }
        for (int it = blockIdx.x; it < 256; it += G) {
            const int g = it >> 5, cb = it & 31, j = tid & 127, cgp = tid >> 7;
            __syncthreads();
            { const int rr = tid >> 3, c4 = (tid & 7) * 4;
#pragma unroll
              for (int q = 0; q < 2; ++q) *(LAS f32x4*)(wtile + (rr + 64 * q) * 32 + c4) = *(const f32x4*)(a.in[4] + (size_t)(g * 128 + rr + 64 * q) * DM + cb * 32 + c4); }
            __syncthreads();
            float ac[8], as[8];
#pragma unroll
            for (int e = 0; e < 8; ++e) { ac[e] = 0.f; as[e] = 0.f; }
#pragma unroll 4
            for (int mp = 0; mp < 128; ++mp) { const float ang = (float)((mp * j) & 127) * (1.f / 128.f); const float cv = __builtin_amdgcn_cosf(ang), sv = __builtin_amdgcn_sinf(ang);
                const f32x4 w0 = *(const LAS f32x4*)(wtile + mp * 32 + cgp * 8), w1 = *(const LAS f32x4*)(wtile + mp * 32 + cgp * 8 + 4);
#pragma unroll
                for (int e = 0; e < 4; ++e) { ac[e] += cv * w0[e]; as[e] += sv * w0[e]; ac[4 + e] += cv * w1[e]; as[4 + e] += sv * w1[e]; } }
            const float inv = 0.08838834764831845f; const int c0 = cb * 32 + cgp * 8;
#pragma unroll
            for (int e = 0; e < 8; ++e) { Wcs[(size_t)(c0 + e) * DM + g * 128 + j] = (bf16_t)f2bf(ac[e] * inv); Wcs[(size_t)(1024 + c0 + e) * DM + g * 128 + j] = (bf16_t)f2bf(as[e] * inv); }
        }
        for (int it = blockIdx.x * 512 + tid; it < 2097152; it += G * 512) {
            const int k = it >> 9, kk0 = (it & 511) * 8; float v[8];
#pragma unroll
            for (int e = 0; e < 8; ++e) { const int kk = kk0 + e; const int idx = (kk <= 2048) ? ((k * kk) & 4095) : ((k * (kk - 2048) + 1024) & 4095);
                v[e] = __builtin_amdgcn_cosf((float)idx * (1.f / 4096.f)) * (1.f / 64.f); }
            u32x4 w; w.x = pk2(v[0], v[1]); w.y = pk2(v[2], v[3]); w.z = pk2(v[4], v[5]); w.w = pk2(v[6], v[7]);
            *(u32x4*)(Cs + (size_t)k * 4096 + kk0) = w;
        }
        if (blockIdx.x == 0 && wid == 0) {
            const float p1 = wave_sum(a.in[16][lane] * a.in[17][lane]), p2 = wave_sum(a.in[18][lane] * a.in[19][lane]);
            if (lane == 0) { *lamp = expf(p1) - expf(p2) + LAM_INIT; *ctr = 0u; }
            ctr[16 + lane] = 0u; ctr[16 + 64 + lane] = 0u;
        }
    }
    SEAM(0);
    if (IN(1)) {
        LAS float* lmod = (LAS float*)lds;
        for (int idx = tid; idx < 8192; idx += 512) { const int b = idx >> 11, w = (idx >> 10) & 1, col = idx & 1023, n = w * 1024 + col; float s = a.in[3][n];
            for (int kc = 0; kc < 8; ++kc) s += modpart[(size_t)((kc * 2 + 0) * 4 + b) * 6144 + n];
            lmod[idx] = s; }
        for (int idx = blockIdx.x * 512 + tid; idx < 49152; idx += G * 512) { const int l = idx / 24576, r = idx % 24576, b = r / 6144, n = r % 6144; float s = (l ? a.in[14] : a.in[3])[n];
            for (int kc = 0; kc < 8; ++kc) s += modpart[(size_t)((kc * 2 + l) * 4 + b) * 6144 + n];
            mod[idx] = s; }
        __syncthreads();
        const float* x = a.in[0];
        for (int p = gw; p < NB * 2049; p += NGW) {
            const int b = p / 2049, n = p % 2049;
            f32x4 v[4], sh[4], sc[4]; float mean, rstd;
#pragma unroll
            for (int j = 0; j < 4; ++j) { sh[j] = *(const LAS f32x4*)(lmod + b * 2048 + 256 * j + 4 * lane); sc[j] = *(const LAS f32x4*)(lmod + b * 2048 + 1024 + 256 * j + 4 * lane); }
            row_load(x + (size_t)(b * SEQ + n) * DM, lane, v); row_stats(v, mean, rstd);
#pragma unroll
            for (int j = 0; j < 4; ++j) v[j] = (v[j] - mean) * rstd * (sc[j] + 1.f) + sh[j];
            if (n == 0 || n == 2048) { row_store_bf16(hbuf + (size_t)(b * SEQ + n) * DM, lane, v); }
            else {
                f32x4 v2[4]; row_load(x + (size_t)(b * SEQ + SEQ - n) * DM, lane, v2); row_stats(v2, mean, rstd);
#pragma unroll
                for (int j = 0; j < 4; ++j) { v2[j] = (v2[j] - mean) * rstd * (sc[j] + 1.f) + sh[j]; const f32x4 s = v[j] + v2[j], d = v[j] - v2[j]; v[j] = s; v2[j] = d; }
                row_store_bf16(hbuf + (size_t)(b * SEQ + n) * DM, lane, v); row_store_bf16(hbuf + (size_t)(b * SEQ + 2048 + n) * DM, lane, v2);
            }
        }
    }
    SEAM(1);
    if (IN(2)) {
        Gemm g{Wcs, hbuf, DM, DM, DM}; OrderU S{G, (int)blockIdx.x}; EpiUt E{Ut};
        gemm_phase<EpiUt, OrderU>(lds, g, S, E);
        for (int it = gw; it < 4096; it += NGW) { const int b = it >> 10, c = it & 1023;
            const bf16_t* hr = hbuf + (size_t)(b * SEQ + 2048) * DM + lane * 16; const bf16_t* wr_ = Wcs + (size_t)c * DM + lane * 16;
            const bf16x8 h0 = *(const bf16x8*)hr, h1 = *(const bf16x8*)(hr + 8), w0 = *(const bf16x8*)wr_, w1 = *(const bf16x8*)(wr_ + 8);
            float s = 0.f;
#pragma unroll
            for (int e = 0; e < 8; ++e) s += bf2f(h0[e]) * bf2f(w0[e]) + bf2f(h1[e]) * bf2f(w1[e]);
            s = wave_sum(s);
            if (lane == 0) Ut[(size_t)(b * 1024 + c) * 4096 + 2048] = (bf16_t)f2bf(s); }
    }
    SEAM(2);
    if (IN(3)) {
        Gemm g{Cs, Ut, 4096, 4096, 4096}; Order S; S.init(64, 4, G, (int)blockIdx.x, 1); EpiResid E{a.in[0], xt, mod + 0 * 24576 + 2 * 1024};
        gemm_phase<EpiResid, Order>(lds, g, S, E);
    }
    SEAM(3);
#define ROWPASS(LNG, LNB, MODL, KSH, KSC) do { \
        const float* lg_ = (LNG); const float* lb_ = (LNB); f32x4 gg[4], bb[4]; \
        _Pragma("unroll") for (int j = 0; j < 4; ++j) { gg[j] = *(const f32x4*)(lg_ + 256 * j + 4 * lane); bb[j] = *(const f32x4*)(lb_ + 256 * j + 4 * lane); } \
        for (int m0 = gw; m0 < MTOK; m0 += 4 * NGW) { f32x4 v[4][4]; float mean[4], rstd[4]; \
            _Pragma("unroll") for (int q = 0; q < 4; ++q) { const int m = m0 + q * NGW; if (m < MTOK) row_load(xt + (size_t)m * DM, lane, v[q]); } \
            _Pragma("unroll") for (int q = 0; q < 4; ++q) row_stats(v[q], mean[q], rstd[q]); \
            _Pragma("unroll") for (int q = 0; q < 4; ++q) { const int m = m0 + q * NGW; if (m < MTOK) { \
                if (lane == 0) *(f32x2*)(rstats + 2 * (size_t)m) = (f32x2){mean[q], rstd[q]}; \
                _Pragma("unroll") for (int j = 0; j < 4; ++j) v[q][j] = (v[q][j] - mean[q]) * rstd[q] * gg[j] + bb[j]; } } \
            _Pragma("unroll") for (int q = 0; q < 4; ++q) row_stats(v[q], mean[q], rstd[q]); \
            _Pragma("unroll") for (int q = 0; q < 4; ++q) { const int m = m0 + q * NGW; if (m < MTOK) { const float* mb_ = mod + (MODL) * 24576 + (m >> 12) * 6144; \
                _Pragma("unroll") for (int j = 0; j < 4; ++j) { const f32x4 sc = *(const f32x4*)(mb_ + (KSC) * 1024 + 256 * j + 4 * lane), sh = *(const f32x4*)(mb_ + (KSH) * 1024 + 256 * j + 4 * lane); \
                    v[q][j] = (v[q][j] - mean[q]) * rstd[q] * (sc + 1.f) + sh; } \
                row_store_bf16(hbuf + (size_t)m * DM, lane, v[q]); } } } } while (0)
#define FFN_UP(WUP, CW, CB) do { Gemm g{hbuf, (WUP), DM, DM, DM}; Order S; S.init(64, 22, G, (int)blockIdx.x, 0); \
        EpiFFN E{act, uedge, (CW), (CB), (LAS float*)(lds + XCH_OFF)}; gemm_phase<EpiFFN, Order>(lds, g, S, E); } while (0)
#define FFN_FIX(CW, CB) do { const float* cw_ = (CW); const float* cb_ = (CB); \
        for (int it = blockIdx.x * 512 + tid; it < 60 * DFF; it += G * 512) { const int bd = it / DFF, ch = it % DFF, pm = (bd / 15) * 16 + (bd % 15); \
            const int cv_ = (ch >> 7) * 256 + (ch & 127), cg_ = cv_ + 128; \
            const float* e0 = uedge + (size_t)(pm * 4) * NUP; const float* e1 = uedge + (size_t)((pm + 1) * 4) * NUP; \
            const float w0v = cw_[ch], w1v = cw_[NUP + ch], w2v = cw_[2 * NUP + ch], bv = cb_[ch]; \
            const float w0g = cw_[DFF + ch], w1g = cw_[NUP + DFF + ch], w2g = cw_[2 * NUP + DFF + ch], bg = cb_[DFF + ch]; \
            const float a254v = e0[2 * NUP + cv_], a255v = e0[3 * NUP + cv_], b0v = e1[cv_], b1v = e1[NUP + cv_]; \
            const float a254g = e0[2 * NUP + cg_], a255g = e0[3 * NUP + cg_], b0g = e1[cg_], b1g = e1[NUP + cg_]; \
            const float vA = w0v * a254v + w1v * a255v + w2v * b0v + bv, gA = w0g * a254g + w1g * a255g + w2g * b0g + bg; \
            const float vB = w0v * a255v + w1v * b0v + w2v * b1v + bv, gB = w0g * a255g + w1g * b0g + w2g * b1g + bg; \
            const size_t rA = (size_t)(pm * 256 + 255); \
            act[rA * DFF + ch] = (bf16_t)f2bf(gelu1(gA) * vA); act[(rA + 1) * DFF + ch] = (bf16_t)f2bf(gelu1(gB) * vB); } } while (0)
#define FFN_FIX_OWN(S, CW, CB) do { const float* cw_ = (CW); const float* cb_ = (CB); Unit fu_; \
        for (int i_ = 0; (S).next(i_, fu_); ++i_) { const int pm = fu_.pm; \
            for (int ch = tid; ch < DFF; ch += 512) { const int cv_ = (ch >> 7) * 256 + (ch & 127), cg_ = cv_ + 128; \
                const float w0v = cw_[ch], w1v = cw_[NUP + ch], w2v = cw_[2 * NUP + ch], bv = cb_[ch]; \
                const float w0g = cw_[DFF + ch], w1g = cw_[NUP + DFF + ch], w2g = cw_[2 * NUP + DFF + ch], bg = cb_[DFF + ch]; \
                const float* em = uedge + (size_t)(pm * 4) * NUP; \
                if ((pm & 15) != 0) { const float* ep = em - (size_t)4 * NUP;      \
                    const float vB = w0v * ep[3 * NUP + cv_] + w1v * em[cv_] + w2v * em[NUP + cv_] + bv, gB = w0g * ep[3 * NUP + cg_] + w1g * em[cg_] + w2g * em[NUP + cg_] + bg; \
                    act[(size_t)(pm * 256) * DFF + ch] = (bf16_t)f2bf(gelu1(gB) * vB); } \
                if ((pm & 15) != 15) { const float* en = em + (size_t)4 * NUP;     \
                    const float vA = w0v * em[2 * NUP + cv_] + w1v * em[3 * NUP + cv_] + w2v * en[cv_] + bv, gA = w0g * em[2 * NUP + cg_] + w1g * em[3 * NUP + cg_] + w2g * en[cg_] + bg; \
                    act[(size_t)(pm * 256 + 255) * DFF + ch] = (bf16_t)f2bf(gelu1(gA) * vA); } } } \
        asm volatile("s_waitcnt vmcnt(0)" ::: "memory"); __syncthreads(); } while (0)
#define FFN_DOWN(WDN, MODL, LNG, LNB, CW, CB) do { Gemm g{act, (WDN), DFF, DFF, DFF}; Order S; S.init(64, 4, G, (int)blockIdx.x, 0); \
        FFN_FIX_OWN(S, CW, CB); \
        EpiResidLN E{xt, xt, mod + (MODL) * 24576 + 5 * 1024, rstats, (LNG), (LNB)}; gemm_phase<EpiResidLN, Order>(lds, g, S, E); } while (0)

    if (IN(4)) ROWPASS(a.in[5], a.in[6], 0, 3, 4);
    SEAM(4);
    if (IN(5)) FFN_UP(Wup0, a.in[8], a.in[9]);
    if (IN(5) && IN(7)) xcd_barrier(xbar);
    if (IN(7)) FFN_DOWN(Wdn0, 0, a.in[5], a.in[6], a.in[8], a.in[9]);
    SEAM(7);
    if (IN(8)) ROWPASS(a.in[11], a.in[12], 1, 0, 1);
    SEAM(8);
    if (IN(9)) {
        { Gemm g{hbuf, Win, DM, DM, DM}; Order S; S.init(64, 8, G, (int)blockIdx.x, 0); EpiQK E{QKb, ctr + 16}; gemm_phase<EpiQK, Order>(lds, g, S, E); }
        { Gemm g{Win, hbuf, DM, DM, DM}; Order S; S.init(4, 64, G, (int)blockIdx.x, 2); EpiVT E{VTb}; gemm_phase<EpiVT, Order>(lds, g, S, E); }
    }
    SEAM(9);
    if (IN(10)) attn_phase(lds, QKb, VTb, hbuf, ctr, a.in[20], lamp);
    SEAM(10);
    if (IN(11)) { Gemm g{hbuf, Wo, DM, DM, DM}; Order S; S.init(64, 4, G, (int)blockIdx.x, 0); EpiResidLN E{xt, xt, mod + 1 * 24576 + 2 * 1024, rstats, a.in[11], a.in[12]}; gemm_phase<EpiResidLN, Order>(lds, g, S, E); }
    SEAM(11);
    if (IN(12)) ROWPASS(a.in[22], a.in[23], 1, 3, 4);
    SEAM(12);
    if (IN(13)) FFN_UP(Wup1, a.in[25], a.in[26]);
    if (IN(13) && IN(15)) xcd_barrier(xbar);
    if (IN(15)) FFN_DOWN(Wdn1, 1, a.in[22], a.in[23], a.in[25], a.in[26]);
    SEAM(15);
    if (IN(16)) {
        const float* lg_ = a.in[28]; const float* lb_ = a.in[29]; f32x4 gg[4], bb[4];
#pragma unroll
        for (int j = 0; j < 4; ++j) { gg[j] = *(const f32x4*)(lg_ + 256 * j + 4 * lane); bb[j] = *(const f32x4*)(lb_ + 256 * j + 4 * lane); }
        for (int m0 = gw; m0 < MTOK; m0 += 4 * NGW) { f32x4 v[4][4]; float mean[4], rstd[4];
#pragma unroll
            for (int q = 0; q < 4; ++q) { const int m = m0 + q * NGW; if (m < MTOK) row_load(xt + (size_t)m * DM, lane, v[q]); }
#pragma unroll
            for (int q = 0; q < 4; ++q) row_stats(v[q], mean[q], rstd[q]);
#pragma unroll
            for (int q = 0; q < 4; ++q) { const int m = m0 + q * NGW; if (m < MTOK) {
#pragma unroll
                for (int j = 0; j < 4; ++j) *(f32x4*)(a.out + (size_t)m * DM + 256 * j + 4 * lane) = (v[q][j] - mean[q]) * rstd[q] * gg[j] + bb[j]; } } }
    }
}

extern "C" void kernel_launch(void* const* d_in, const int* in_sizes, int n_in, void* d_out, int out_size, void* d_ws, size_t ws_size, hipStream_t stream) {
    static int grid = 0;
    if (grid == 0) {
        if (n_in != 30 || out_size != MTOK * DM || ws_size < WS_END) { fprintf(stderr, "kernel_launch: unexpected shapes (n_in %d, out %d, ws %zu)\n", n_in, out_size, ws_size); grid = -1; return; }
        int dev = 0, cus = 0, per_cu = 0;
        hipGetDevice(&dev); hipDeviceGetAttribute(&cus, hipDeviceAttributeMultiprocessorCount, dev);
        if (hipFuncSetAttribute((const void*)mk_fwd, hipFuncAttributeMaxDynamicSharedMemorySize, LDS_BYTES) != hipSuccess) { fprintf(stderr, "kernel_launch: hipFuncSetAttribute failed\n"); grid = -1; return; }
        if (hipOccupancyMaxActiveBlocksPerMultiprocessor(&per_cu, (const void*)mk_fwd, 512, LDS_BYTES) != hipSuccess || per_cu < 1) { fprintf(stderr, "kernel_launch: occupancy query says %d\n", per_cu); per_cu = 1; }
        (void)hipGetLastError();
        grid = cus * 1;
        if (grid <= 0) grid = 256;
    }
    if (grid < 0) return;
    Args a{};
    for (int i = 0; i < 30; ++i) a.in[i] = (const float*)d_in[i];
    a.out = (float*)d_out; a.ws = (unsigned char*)d_ws;
#if MK_ONE_LAUNCH
    if (hipMemsetAsync((char*)d_ws + WS_BAR, 0, 16384, stream) != hipSuccess) { fprintf(stderr, "kernel_launch: memset failed\n"); return; }
    a.ph_lo = 0; a.ph_hi = N_PHASES;
    void* args[] = {&a};
    hipError_t e = hipLaunchCooperativeKernel((const void*)mk_fwd, dim3(grid), dim3(512), args, LDS_BYTES, stream);
    if (e != hipSuccess) fprintf(stderr, "kernel_launch: cooperative launch failed: %s (grid %d)\n", hipGetErrorString(e), grid);
#else
    for (int p = 0; p < N_PHASES; ++p) {
        a.ph_lo = p; a.ph_hi = p + 1;
        hipLaunchKernelGGL(mk_fwd, dim3(grid), dim3(512), LDS_BYTES, stream, a);
    }
#endif
}
```

```cpp
#include <hip/hip_runtime.h>
#include <hip/hip_cooperative_groups.h>
#include <cstdio>
#include <cstdint>
namespace cg = cooperative_groups;

#ifndef MK_ONE_LAUNCH
#define MK_ONE_LAUNCH 1
#endif

#define LAS __attribute__((address_space(3)))
typedef unsigned short bf16_t;
typedef short bf16x8 __attribute__((ext_vector_type(8)));
typedef float f32x4 __attribute__((ext_vector_type(4)));
typedef float f32x2 __attribute__((ext_vector_type(2)));
typedef float f32x16 __attribute__((ext_vector_type(16)));
typedef unsigned u32x4 __attribute__((ext_vector_type(4)));
typedef unsigned u32x2 __attribute__((ext_vector_type(2)));

constexpr int NB = 4, SEQ = 4096, DM = 1024, MTOK = NB * SEQ, DFF = 2816, NUP = 2 * DFF, NH = 8;
constexpr float LN_EPS = 1e-5f;
constexpr float ALPHA = 1.4142135623730951f;
constexpr float LAM_INIT = 0.35550906759096926f;
constexpr float C2 = 0.125f * 1.4426950408889634f;
constexpr float LOG2E = 1.4426950408889634f;

constexpr size_t MiB = 1u << 20;
constexpr size_t WS_MODPART = 0;
constexpr size_t WS_MOD = 2 * MiB;
constexpr size_t WS_SCAL = 2 * MiB + 512 * 1024;
constexpr size_t WS_BAR = 2 * MiB + 768 * 1024;
constexpr size_t WS_STATS = 2 * MiB + 896 * 1024;
constexpr size_t WS_UEDGE = 3 * MiB;
constexpr size_t WS_XT = 9 * MiB;
constexpr size_t WS_H = 73 * MiB;
constexpr size_t WS_CS = 105 * MiB;
constexpr size_t WS_UT = 137 * MiB;
constexpr size_t WS_ACT = 105 * MiB;
constexpr size_t WS_QK = 105 * MiB;
constexpr size_t WS_VT = 169 * MiB;
constexpr size_t WS_WCS = 211 * MiB;
constexpr size_t WS_UP0 = 215 * MiB;
constexpr size_t WS_DN0 = 226 * MiB;
constexpr size_t WS_WIN = WS_DN0 + 5632 * 1024;
constexpr size_t WS_WO = WS_WIN + 6 * MiB;
constexpr size_t WS_UP1 = WS_WO + 2 * MiB;
constexpr size_t WS_DN1 = WS_UP1 + 11 * MiB;
constexpr size_t WS_END = WS_DN1 + 5632 * 1024;
static_assert(WS_END <= 256 * MiB, "workspace map");

constexpr int LDS_BYTES = 151552;
constexpr int CWL_OFF = 139392;
constexpr int XCH_OFF = 131072;

__device__ __forceinline__ unsigned f2bf(float f) { unsigned u = __builtin_bit_cast(unsigned, f); return (u + 0x7fffu + ((u >> 16) & 1u)) >> 16; }
__device__ __forceinline__ unsigned pk2(float lo, float hi) { return f2bf(lo) | (f2bf(hi) << 16); }
__device__ __forceinline__ unsigned cvt_pk_bf16(float lo, float hi) { unsigned r; asm volatile("v_cvt_pk_bf16_f32 %0, %1, %2" : "=v"(r) : "v"(lo), "v"(hi)); return r; }
__device__ __forceinline__ float bf2f(short s) { return __builtin_bit_cast(float, ((unsigned)(unsigned short)s) << 16); }
__device__ __forceinline__ float wave_sum(float v) {
#pragma unroll
    for (int o = 1; o < 64; o <<= 1) v += __shfl_xor(v, o);
    return v;
}
__device__ __forceinline__ float max3f(float a, float b, float c) { float r; asm("v_max3_f32 %0, %1, %2, %3" : "=v"(r) : "v"(a), "v"(b), "v"(c)); return r; }
__device__ __forceinline__ float half_swap_max(float m) { auto rr = __builtin_amdgcn_permlane32_swap(__float_as_uint(m), __float_as_uint(m), false, false); return fmaxf(__uint_as_float(rr[0]), __uint_as_float(rr[1])); }
__device__ __forceinline__ float half_swap_sum(float m) { auto rr = __builtin_amdgcn_permlane32_swap(__float_as_uint(m), __float_as_uint(m), false, false); return __uint_as_float(rr[0]) + __uint_as_float(rr[1]); }

__device__ __forceinline__ f32x2 gelu_pk(f32x2 v) {
    const f32x2 av = __builtin_elementwise_abs(v), d = av * 0.2316418882f + 1.0f;
    f32x2 t; t.x = __builtin_amdgcn_rcpf(d.x); t.y = __builtin_amdgcn_rcpf(d.y);
    f32x2 q = t * 0.5307027145f + (-0.7265760135f); q = q * t + 0.7107068705f; q = q * t + (-0.142248368f); q = q * t + 0.127414796f; q = q * t;
    const f32x2 s = (v * v) * (-0.72134752044f);
    f32x2 e; e.x = __builtin_amdgcn_exp2f(s.x); e.y = __builtin_amdgcn_exp2f(s.y);
    const f32x2 m = v * (q * e), r = v - m;
    f32x2 o; o.x = v.x < 0.f ? m.x : r.x; o.y = v.y < 0.f ? m.y : r.y; return o;
}
__device__ __forceinline__ float gelu1(float x) { f32x2 r = gelu_pk((f32x2){x, x}); return r.x; }

constexpr int BM = 256, BK = 64, HALF = 128, HTB = HALF * BK * 2, NXCD = 8, WGM = 8;
__device__ __forceinline__ int lds_byte(int r, int c) { const int st = (r >> 4) * 2 + (c >> 5), rr = r & 15, cc = c & 31, ob = rr * 64 + cc * 2; return st * 1024 + (ob ^ (((ob >> 9) & 1) << 5)); }
__device__ __forceinline__ void stage_rc(int b, int& R, int& C) { const int st = b / 1024, sb = b % 1024, swz = sb ^ (((sb >> 9) & 1) << 5); R = (st >> 1) * 16 + swz / 64; C = (st & 1) * 32 + (swz % 64) / 2; }
__device__ __forceinline__ int perm32(int rho) { const int n = rho >> 4, i = rho & 15; return 8 * (i >> 2) + 4 * n + (i & 3); }

struct Unit { int pm, pn, am, bn; };
struct Gemm { const bf16_t* A; const bf16_t* Bt; int lda, ldb, K; };

struct Order {
    int nM, nN, nwg, G, c, mode;
    __device__ void init(int nM_, int nN_, int G_, int c_, int mode_) { nM = nM_; nN = nN_; nwg = nM * nN; G = G_; c = c_; mode = mode_; }
    __device__ bool next(int i, Unit& u) const {
        const long L = (long)i * G + c; if (L >= nwg) return false;
        int wgid = (int)L; { const int q = nwg / NXCD, r = nwg % NXCD, xcd = wgid % NXCD, off = wgid / NXCD; wgid = (xcd < r ? xcd * (q + 1) : r * (q + 1) + (xcd - r) * q) + off; }
        const int nig = WGM * nN, gid = wgid / nig, fm = gid * WGM, gsz = (nM - fm) < WGM ? (nM - fm) : WGM;
        u.pm = fm + ((wgid % nig) % gsz); u.pn = (wgid % nig) / gsz;
        if (mode == 1) { u.am = u.pm & 15; u.bn = (u.pm >> 4) * 4 + u.pn; }
        else if (mode == 2) { u.am = 8 + u.pm; u.bn = u.pn; }
        else { u.am = u.pm; u.bn = u.pn; }
        return true;
    }
};
struct OrderU {
    int G, c;
    __device__ bool next(int i, Unit& u) const {
        const long L = (long)i * G + c; if (L >= 256) return false;
        const int l = (int)L, pnq = l & 7, pmq = (l >> 3) & 3, part = (l >> 5) & 1, b = l >> 6;
        u.am = part * 4 + pmq; u.bn = b * 16 + part * 8 + pnq; u.pm = u.am; u.pn = u.bn; return true;
    }
};

struct EpiQK {
    __device__ __forceinline__ void prefetch(const Unit&, int, int, int) const {}
    static constexpr bool PERM = true;
    bf16_t* O; unsigned* kmax2;
    __device__ __forceinline__ void operator()(f32x4 (&acc)[2][2][4][2], const Unit& u, int wid, int lane, int par) const {
        const int wr = wid >> 2, wc = wid & 3, fr = lane & 15, fq = lane >> 4;
        if (u.pn >= 4) {
            float mx0 = 0.f, mx1 = 0.f;
#pragma unroll
            for (int ai = 0; ai < 2; ++ai)
#pragma unroll
                for (int m = 0; m < 4; ++m)
#pragma unroll
                    for (int bj = 0; bj < 2; ++bj) { const f32x4 v0 = acc[ai][bj][m][0], v1 = acc[ai][bj][m][1];
                        float q = (v0[0] * v0[0] + v0[1] * v0[1]) + (v0[2] * v0[2] + v0[3] * v0[3]) + (v1[0] * v1[0] + v1[1] * v1[1]) + (v1[2] * v1[2] + v1[3] * v1[3]);
                        q += __shfl_xor(q, 16); q += __shfl_xor(q, 32);
                        if (bj == 0) mx0 = fmaxf(mx0, q); else mx1 = fmaxf(mx1, q); }
#pragma unroll
            for (int o = 1; o < 16; o <<= 1) { mx0 = fmaxf(mx0, __shfl_xor(mx0, o)); mx1 = fmaxf(mx1, __shfl_xor(mx1, o)); }
            if (lane == 0) { const int b = u.pm >> 4, hd = 2 * (u.pn - 4);
                atomicMax(kmax2 + ((b * 8 + hd) * 2 + (wc >> 1)) * 2 + (wc & 1), __float_as_uint(mx0));
                atomicMax(kmax2 + ((b * 8 + hd + 1) * 2 + (wc >> 1)) * 2 + (wc & 1), __float_as_uint(mx1)); }
        }
        const float sc = (u.pn < 4) ? C2 : 1.f;
        const int row0 = u.pm * BM + wr * 64 + fr, col0 = u.pn * BM + wc * 32 + 8 * fq;
#pragma unroll
        for (int ai = 0; ai < 2; ++ai)
#pragma unroll
            for (int m = 0; m < 4; ++m) { bf16_t* rowp = O + (size_t)(row0 + ai * HALF + m * 16) * 2048 + col0;
#pragma unroll
                for (int bj = 0; bj < 2; ++bj) { const f32x4 v0 = acc[ai][bj][m][0] * sc, v1 = acc[ai][bj][m][1] * sc;
                    u32x4 w; w.x = cvt_pk_bf16(v0[0], v0[1]); w.y = cvt_pk_bf16(v0[2], v0[3]); w.z = cvt_pk_bf16(v1[0], v1[1]); w.w = cvt_pk_bf16(v1[2], v1[3]);
                    *(u32x4*)(rowp + bj * HALF) = w; } }
    }
};
struct EpiUt {
    __device__ __forceinline__ void prefetch(const Unit&, int, int, int) const {}
    static constexpr bool PERM = true;
    bf16_t* O;
    __device__ __forceinline__ void operator()(f32x4 (&acc)[2][2][4][2], const Unit& u, int wid, int lane, int par) const {
        const int wr = wid >> 2, wc = wid & 3, fr = lane & 15, fq = lane >> 4;
        const int b = u.bn >> 4, kk0 = (u.bn & 15) * 256 + wc * 32 + 8 * fq;
        const int c0 = (u.am & 3) * 256 + wr * 64 + fr;
#pragma unroll
        for (int ai = 0; ai < 2; ++ai)
#pragma unroll
            for (int m = 0; m < 4; ++m) { bf16_t* rowp = O + ((size_t)(b * 1024 + c0 + ai * HALF + m * 16)) * 4096 + kk0;
#pragma unroll
                for (int bj = 0; bj < 2; ++bj) { const f32x4 v0 = acc[ai][bj][m][0], v1 = acc[ai][bj][m][1];
                    u32x4 w; w.x = cvt_pk_bf16(v0[0], v0[1]); w.y = cvt_pk_bf16(v0[2], v0[3]); w.z = cvt_pk_bf16(v1[0], v1[1]); w.w = cvt_pk_bf16(v1[2], v1[3]);
                    if (kk0 + bj * HALF == 2048) {
                        bf16_t* p = rowp + bj * HALF;
                        p[1] = (bf16_t)(w.x >> 16); *(unsigned*)(p + 2) = w.y; *(unsigned*)(p + 4) = w.z; *(unsigned*)(p + 6) = w.w;
                    } else *(u32x4*)(rowp + bj * HALF) = w; } }
    }
};
struct EpiVT {
    __device__ __forceinline__ void prefetch(const Unit&, int, int, int) const {}
    static constexpr bool PERM = true;
    bf16_t* O;
    __device__ __forceinline__ void operator()(f32x4 (&acc)[2][2][4][2], const Unit& u, int wid, int lane, int par) const {
        const int wr = wid >> 2, wc = wid & 3, fr = lane & 15, fq = lane >> 4;
        const int b = u.bn >> 4, n0 = (u.bn & 15) * 256 + wc * 32 + 8 * fq;
        const int odd = (n0 >> 3) & 1, base16 = n0 & ~15;
        const int d0 = u.pm * 256 + wr * 64 + fr;
#pragma unroll
        for (int ai = 0; ai < 2; ++ai)
#pragma unroll
            for (int m = 0; m < 4; ++m) { bf16_t* rowp = O + ((size_t)(b * 1024 + d0 + ai * HALF + m * 16)) * 4096 + base16;
#pragma unroll
                for (int bj = 0; bj < 2; ++bj) { const f32x4 v0 = acc[ai][bj][m][0], v1 = acc[ai][bj][m][1];
                    u32x2 w0, w1; w0.x = cvt_pk_bf16(v0[0], v0[1]); w0.y = cvt_pk_bf16(v0[2], v0[3]); w1.x = cvt_pk_bf16(v1[0], v1[1]); w1.y = cvt_pk_bf16(v1[2], v1[3]);
                    *(u32x2*)(rowp + bj * HALF + (odd ? 4 : 0)) = w0; *(u32x2*)(rowp + bj * HALF + (odd ? 12 : 8)) = w1; } }
    }
};
struct EpiResid {
    __device__ __forceinline__ void prefetch(const Unit&, int, int, int) const {}
    static constexpr bool PERM = false;
    const float* X; float* T; const float* gate;
    __device__ __forceinline__ void operator()(f32x4 (&acc)[2][2][4][2], const Unit& u, int wid, int lane, int par) const {
        const int wr = wid >> 2, wc = wid & 3, fr = lane & 15, fq = lane >> 4;
        const int b = u.pm >> 4, row0 = u.pm * BM + wr * 64 + fr, col0 = u.pn * BM + wc * 32 + 4 * fq;
#pragma unroll
        for (int bj = 0; bj < 2; ++bj)
#pragma unroll
            for (int n = 0; n < 2; ++n) { const int col = col0 + bj * HALF + n * 16; const f32x4 gv = *(const f32x4*)(gate + b * 6144 + col);
#pragma unroll
                for (int ai = 0; ai < 2; ++ai) {
#pragma unroll
                    for (int m = 0; m < 4; ++m) { const size_t off = (size_t)(row0 + ai * HALF + m * 16) * DM + col;
                        const f32x4 xv = *(const f32x4*)(X + off); *(f32x4*)(T + off) = xv * ALPHA + gv * acc[ai][bj][m][n]; }
                    asm volatile("" ::: "memory"); } }
    }
};
struct EpiResidLN {
    __device__ __forceinline__ void prefetch(const Unit&, int, int, int) const {}
    static constexpr bool PERM = false;
    const float* X; float* T; const float* gate; const float* stats; const float* lg; const float* lb;
    __device__ __forceinline__ void operator()(f32x4 (&acc)[2][2][4][2], const Unit& u, int wid, int lane, int par) const {
        const int wr = wid >> 2, wc = wid & 3, fr = lane & 15, fq = lane >> 4;
        const int b = u.pm >> 4, row0 = u.pm * BM + wr * 64 + fr, col0 = u.pn * BM + wc * 32 + 4 * fq;
        f32x2 st[2][4];
#pragma unroll
        for (int ai = 0; ai < 2; ++ai)
#pragma unroll
            for (int m = 0; m < 4; ++m) st[ai][m] = *(const f32x2*)(stats + 2 * (size_t)(row0 + ai * HALF + m * 16));
#pragma unroll
        for (int bj = 0; bj < 2; ++bj)
#pragma unroll
            for (int n = 0; n < 2; ++n) { const int col = col0 + bj * HALF + n * 16; const f32x4 gv = *(const f32x4*)(gate + b * 6144 + col);
                const f32x4 lgv = *(const f32x4*)(lg + col), lbv = *(const f32x4*)(lb + col);
#pragma unroll
                for (int ai = 0; ai < 2; ++ai) {
#pragma unroll
                    for (int m = 0; m < 4; ++m) { const size_t off = (size_t)(row0 + ai * HALF + m * 16) * DM + col;
                        const f32x4 xv = *(const f32x4*)(X + off); const f32x4 x1 = (xv - st[ai][m].x) * st[ai][m].y * lgv + lbv;
                        *(f32x4*)(T + off) = x1 * ALPHA + gv * acc[ai][bj][m][n]; }
                    asm volatile("" ::: "memory"); } }
    }
};
__device__ __forceinline__ float dpp_up(float prev_lane0_src, float cur) {
    return __builtin_bit_cast(float, __builtin_amdgcn_update_dpp(__builtin_bit_cast(int, prev_lane0_src), __builtin_bit_cast(int, cur), 0x111, 0xf, 0xf, false)); }
__device__ __forceinline__ float dpp_dn(float next_lane15_src, float cur) {
    return __builtin_bit_cast(float, __builtin_amdgcn_update_dpp(__builtin_bit_cast(int, next_lane15_src), __builtin_bit_cast(int, cur), 0x101, 0xf, 0xf, false)); }
__device__ __forceinline__ float dpp_ror1(float v) { return __builtin_bit_cast(float, __builtin_amdgcn_update_dpp(0, __builtin_bit_cast(int, v), 0x121, 0xf, 0xf, false)); }
__device__ __forceinline__ float dpp_ror15(float v) { return __builtin_bit_cast(float, __builtin_amdgcn_update_dpp(0, __builtin_bit_cast(int, v), 0x12F, 0xf, 0xf, false)); }

struct EpiFFN {
    static constexpr bool PERM = true;
    bf16_t* act; float* uedge; const float* cw; const float* cb; LAS float* xch; LAS unsigned char* wl;
    __device__ __forceinline__ void prefetch(const Unit& u, int wid, int lane, int par) const {
        if (wid < 4) { const int a0 = 2 * wid + (lane >> 5);
            const float* src = ((a0 & 3) == 3 ? cb : cw + (a0 & 3) * NUP) + (a0 >> 2) * DFF + u.pn * 128 + 4 * (lane & 31);
            __builtin_amdgcn_global_load_lds((const unsigned*)src, (LAS unsigned*)(wl + par * 4096 + wid * 1024), 16, 0, 0); }
    }
    __device__ __forceinline__ void operator()(f32x4 (&acc)[2][2][4][2], const Unit& u, int wid, int lane, int par) const {
        const int wr = wid >> 2, wc = wid & 3, fr = lane & 15, fq = lane >> 4;
        LAS f32x4* X = (LAS f32x4*)xch;
#pragma unroll
        for (int ai = 0; ai < 2; ++ai)
#pragma unroll
            for (int bj = 0; bj < 2; ++bj)
#pragma unroll
                for (int n = 0; n < 2; ++n) {
                    if (fr == 0)  X[(((((wid * 2 + ai) * 2 + 0) * 2 + bj) * 2 + n) * 4) + fq] = acc[ai][bj][0][n];
                    if (fr == 15) X[(((((wid * 2 + ai) * 2 + 1) * 2 + bj) * 2 + n) * 4) + fq] = acc[ai][bj][3][n];
                }
        {
            const int colb = u.pn * 256 + wc * 32 + 8 * fq;
            if (wr == 0 && fr < 2) {
#pragma unroll
                for (int bj = 0; bj < 2; ++bj)
#pragma unroll
                    for (int n = 0; n < 2; ++n) *(f32x4*)(uedge + (size_t)(u.pm * 4 + fr) * NUP + colb + bj * HALF + 4 * n) = acc[0][bj][0][n];
            }
            if (wr == 1 && fr >= 14) {
#pragma unroll
                for (int bj = 0; bj < 2; ++bj)
#pragma unroll
                    for (int n = 0; n < 2; ++n) *(f32x4*)(uedge + (size_t)(u.pm * 4 + 2 + (fr - 14)) * NUP + colb + bj * HALF + 4 * n) = acc[1][bj][3][n];
            }
        }
        asm volatile("s_waitcnt lgkmcnt(0)\n\ts_barrier" ::: "memory");
        const int ch0 = u.pn * 128 + wc * 32 + 8 * fq;
#pragma unroll
        for (int n = 0; n < 2; ++n) {
            const LAS float* W = (const LAS float*)(wl + par * 4096) + wc * 32 + 8 * fq + 4 * n;
            const f32x4 wv0 = *(const LAS f32x4*)(W), wv1 = *(const LAS f32x4*)(W + 128), wv2 = *(const LAS f32x4*)(W + 256), bv = *(const LAS f32x4*)(W + 384);
            const f32x4 wg0 = *(const LAS f32x4*)(W + 512), wg1 = *(const LAS f32x4*)(W + 640), wg2 = *(const LAS f32x4*)(W + 768), bg = *(const LAS f32x4*)(W + 896);
#pragma unroll
            for (int ai = 0; ai < 2; ++ai) {
                const bool has_prev = !(wr == 0 && ai == 0), has_next = !(wr == 1 && ai == 1);
                const int pw = (wr == 1) ? wid - 4 : wid + 4, pai = (wr == 1) ? ai : 0;
                const int nw = (wr == 0) ? wid + 4 : wid - 4, nai = (wr == 0) ? ai : 1;
                f32x4 pv = (f32x4){0.f, 0.f, 0.f, 0.f}, pg = pv, nv = pv, ng = pv;
                if (has_prev) { pv = X[(((((pw * 2 + pai) * 2 + 1) * 2 + 0) * 2 + n) * 4) + fq]; pg = X[(((((pw * 2 + pai) * 2 + 1) * 2 + 1) * 2 + n) * 4) + fq]; }
                if (has_next) { nv = X[(((((nw * 2 + nai) * 2 + 0) * 2 + 0) * 2 + n) * 4) + fq]; ng = X[(((((nw * 2 + nai) * 2 + 0) * 2 + 1) * 2 + n) * 4) + fq]; }
#pragma unroll
                for (int m = 0; m < 4; ++m) {
                    const f32x4 cv = acc[ai][0][m][n], cg = acc[ai][1][m][n];
                    f32x4 uv, ug, dv, dg;
#pragma unroll
                    for (int e = 0; e < 4; ++e) {
                        const float xv = (m == 0) ? pv[e] : dpp_ror1(pv[e]), xg = (m == 0) ? pg[e] : dpp_ror1(pg[e]);
                        uv[e] = dpp_up(xv, cv[e]); ug[e] = dpp_up(xg, cg[e]);
                        const float yv = (m == 3) ? nv[e] : dpp_ror15(acc[ai][0][m + 1 > 3 ? 3 : m + 1][n][e]), yg = (m == 3) ? ng[e] : dpp_ror15(acc[ai][1][m + 1 > 3 ? 3 : m + 1][n][e]);
                        dv[e] = dpp_dn(yv, cv[e]); dg[e] = dpp_dn(yg, cg[e]);
                    }
                    const f32x4 val = wv0 * uv + wv1 * cv + wv2 * dv + bv;
                    const f32x4 gat = wg0 * ug + wg1 * cg + wg2 * dg + bg;
                    const f32x2 g01 = gelu_pk((f32x2){gat[0], gat[1]}), g23 = gelu_pk((f32x2){gat[2], gat[3]});
                    f32x4 r; r.x = __uint_as_float(cvt_pk_bf16(g01.x * val[0], g01.y * val[1])); r.y = __uint_as_float(cvt_pk_bf16(g23.x * val[2], g23.y * val[3])); r.z = 0.f; r.w = 0.f;
                    acc[ai][0][m][n] = r;
                    pv = cv; pg = cg;
                }
            }
        }
        const int row0 = u.pm * BM + wr * 64 + fr;
#pragma unroll
        for (int ai = 0; ai < 2; ++ai)
#pragma unroll
            for (int m = 0; m < 4; ++m) {
                u32x4 w; w.x = __float_as_uint(acc[ai][0][m][0].x); w.y = __float_as_uint(acc[ai][0][m][0].y); w.z = __float_as_uint(acc[ai][0][m][1].x); w.w = __float_as_uint(acc[ai][0][m][1].y);
                *(u32x4*)(act + (size_t)(row0 + ai * HALF + m * 16) * DFF + ch0) = w;
            }
    }
};

template <class Epi, class Sched>
__device__ __forceinline__ void gemm_phase(LAS unsigned char* lds, const Gemm g, const Sched& S, const Epi& E) {
    const int tid = threadIdx.x, wid = __builtin_amdgcn_readfirstlane(tid >> 6), lane = tid & 63, wr = wid >> 2, wc = wid & 3, fr = lane & 15, fq = lane >> 4;
    const int K = g.K, nt = K / BK;
    unsigned voffA[2], voffB[2];
#pragma unroll
    for (int i = 0; i < 2; ++i) { int R, C; stage_rc(tid * 16 + i * 8192, R, C); const int Rb = Epi::PERM ? ((R & ~31) + perm32(R & 31)) : R;
        voffA[i] = (unsigned)(R * g.lda + C) * 2u; voffB[i] = (unsigned)(Rb * g.ldb + C) * 2u; }
    const size_t kstep = (size_t)(BK * 2);
    const size_t hA = (size_t)HALF * g.lda * 2, hB = (size_t)HALF * g.ldb * 2, tA = 2 * hA, tB = 2 * hB;
    const unsigned ldsw = (unsigned)wid * 1024u;
    const int aoff = lds_byte(wr * 64 + fr, fq * 8), boff = lds_byte(wc * 32 + fr, fq * 8);
#define PG8_SA(b, h) (((b) * 2 + (h)) * HTB)
#define PG8_SB(b, h) ((4 + (b) * 2 + (h)) * HTB)
#define PG8_STAGE(bufoff, gbase, voff) do { _Pragma("unroll") for (int _i = 0; _i < 2; ++_i) \
        __builtin_amdgcn_global_load_lds((const unsigned*)((const char*)(gbase) + (voff)[_i]), (LAS unsigned*)(lds + (bufoff) + ldsw + _i * 8192), 16, 0, 0); } while (0)
#define PG8_LDA(dst, b, h) do { _Pragma("unroll") for (int m = 0; m < 4; ++m) _Pragma("unroll") for (int k = 0; k < 2; ++k) dst[m][k] = *(const LAS bf16x8*)(lds + PG8_SA(b, h) + aoff + m * 2048 + k * 1024); } while (0)
#define PG8_LDB(dst, b, h) do { _Pragma("unroll") for (int n = 0; n < 2; ++n) _Pragma("unroll") for (int k = 0; k < 2; ++k) dst[n][k] = *(const LAS bf16x8*)(lds + PG8_SB(b, h) + boff + n * 2048 + k * 1024); } while (0)
#define PG8_MMA(ai, bj, At, Bt) do { __builtin_amdgcn_s_setprio(1); _Pragma("unroll") for (int m = 0; m < 4; ++m) _Pragma("unroll") for (int n = 0; n < 2; ++n) _Pragma("unroll") for (int k = 0; k < 2; ++k) \
        acc[ai][bj][m][n] = __builtin_amdgcn_mfma_f32_16x16x32_bf16(Bt[n][k], At[m][k], acc[ai][bj][m][n], 0, 0, 0); __builtin_amdgcn_s_setprio(0); } while (0)
#define PG8_WAIT_V(n) asm volatile("s_waitcnt vmcnt(" #n ")" ::: "memory")
#define PG8_WAIT_L(n) asm volatile("s_waitcnt lgkmcnt(" #n ")" ::: "memory")
#define PG8_BAR __builtin_amdgcn_s_barrier()
#define PG8_SCHED __builtin_amdgcn_sched_barrier(0)
    Unit cur, nxt; int ui = 0;
    if (!S.next(0, cur)) return;
    f32x4 acc[2][2][4][2];
#pragma unroll
    for (int a = 0; a < 2; ++a)
#pragma unroll
        for (int b = 0; b < 2; ++b)
#pragma unroll
            for (int m = 0; m < 4; ++m)
#pragma unroll
                for (int n = 0; n < 2; ++n) acc[a][b][m][n] = (f32x4){0.f, 0.f, 0.f, 0.f};
    bf16x8 At[4][2], B0[2][2], B1[2][2];
    const char* cA = (const char*)g.A + (size_t)cur.am * tA; const char* cB = (const char*)g.Bt + (size_t)cur.bn * tB;
    E.prefetch(cur, wid, lane, 0);
    PG8_STAGE(PG8_SB(0, 0), cB, voffB); PG8_STAGE(PG8_SB(0, 1), cB + hB, voffB); PG8_STAGE(PG8_SA(0, 0), cA, voffA); PG8_STAGE(PG8_SA(0, 1), cA + hA, voffA);
    if (wr == 1) PG8_BAR;
    PG8_WAIT_V(2); PG8_BAR;
    PG8_STAGE(PG8_SB(1, 0), cB + kstep, voffB); PG8_STAGE(PG8_SA(1, 0), cA + kstep, voffA); PG8_STAGE(PG8_SB(1, 1), cB + hB + kstep, voffB);
    PG8_WAIT_V(6); PG8_BAR;
    for (;;) {
        const bool has_next = S.next(ui + 1, nxt);
        const char* nA = has_next ? (const char*)g.A + (size_t)nxt.am * tA : cA; const char* nB = has_next ? (const char*)g.Bt + (size_t)nxt.bn * tB : cB;
        for (int t = 0; t < nt; t += 2) {
            const bool last = (t == nt - 2);
            const char* a1 = cA + (size_t)(t + 1) * kstep;
            const char* a2 = last ? nA : cA + (size_t)(t + 2) * kstep; const char* b2 = last ? nB : cB + (size_t)(t + 2) * kstep;
            const char* a3 = a2 + kstep; const char* b3 = b2 + kstep;
            PG8_LDB(B0, 0, 0); PG8_LDB(B1, 0, 1); PG8_SCHED; PG8_LDA(At, 0, 0); PG8_STAGE(PG8_SA(1, 1), a1 + hA, voffA);
            PG8_WAIT_V(8); PG8_WAIT_L(0); PG8_BAR; PG8_MMA(0, 0, At, B0); PG8_MMA(0, 1, At, B1); PG8_BAR; PG8_SCHED;
            PG8_LDA(At, 0, 1); PG8_STAGE(PG8_SB(0, 0), b2, voffB); PG8_STAGE(PG8_SB(0, 1), b2 + hB, voffB); PG8_STAGE(PG8_SA(0, 0), a2, voffA);
            PG8_WAIT_V(8); PG8_WAIT_L(0); PG8_BAR; PG8_MMA(1, 0, At, B0); PG8_MMA(1, 1, At, B1); PG8_BAR; PG8_SCHED;
            PG8_LDB(B0, 1, 0); PG8_LDB(B1, 1, 1); PG8_SCHED; PG8_LDA(At, 1, 0); PG8_STAGE(PG8_SA(0, 1), a2 + hA, voffA);
            PG8_WAIT_V(8); PG8_WAIT_L(0); PG8_BAR; PG8_MMA(0, 0, At, B0); PG8_MMA(0, 1, At, B1); PG8_BAR; PG8_SCHED;
            PG8_LDA(At, 1, 1); PG8_STAGE(PG8_SB(1, 0), b3, voffB); PG8_STAGE(PG8_SB(1, 1), b3 + hB, voffB); PG8_STAGE(PG8_SA(1, 0), a3, voffA);
            PG8_WAIT_V(8); PG8_WAIT_L(0); PG8_BAR; PG8_MMA(1, 0, At, B0); PG8_MMA(1, 1, At, B1); PG8_BAR; PG8_SCHED;
        }
        if (wr == 0) PG8_BAR;
        E(acc, cur, wid, lane, ui & 1);
        if (!has_next) break;
        E.prefetch(nxt, wid, lane, (ui + 1) & 1);
#pragma unroll
        for (int a = 0; a < 2; ++a)
#pragma unroll
            for (int b = 0; b < 2; ++b)
#pragma unroll
                for (int m = 0; m < 4; ++m)
#pragma unroll
                    for (int n = 0; n < 2; ++n) acc[a][b][m][n] = (f32x4){0.f, 0.f, 0.f, 0.f};
        cur = nxt; cA = nA; cB = nB; ++ui;
        if (wr == 1) PG8_BAR;
    }
    PG8_WAIT_V(0);
    PG8_BAR;
#undef PG8_SA
#undef PG8_SB
#undef PG8_STAGE
#undef PG8_LDA
#undef PG8_LDB
#undef PG8_MMA
#undef PG8_WAIT_V
#undef PG8_WAIT_L
#undef PG8_BAR
#undef PG8_SCHED
}

template <int MODE> __device__ __forceinline__ int wrow(int n) {
    if (MODE == 0) return n;
    return n < DFF ? (n / 128) * 256 + (n % 128) : ((n - DFF) / 128) * 256 + 128 + ((n - DFF) % 128);
}
template <int MODE> __device__ __forceinline__ void transpose_item(const float* W, int K, int N, bf16_t* WT, LAS float* scr, int item, int lane) {
    const int nblk = N / 32, kb = item / nblk, nb = item % nblk, k0 = 64 * kb, n0 = 32 * nb;
#pragma unroll
    for (int i = 0; i < 32; ++i) { const int kk = 2 * i + (lane >> 5); scr[kk * 33 + (lane & 31)] = W[(size_t)(k0 + kk) * N + n0 + (lane & 31)]; }
    asm volatile("s_waitcnt lgkmcnt(0)" ::: "memory");
    const int c = lane & 7;
#pragma unroll
    for (int j = 0; j < 4; ++j) { const int n = (lane >> 3) + 8 * j; const LAS float* s = scr + (8 * c) * 33 + n;
        u32x4 o; o.x = pk2(s[0 * 33], s[1 * 33]); o.y = pk2(s[2 * 33], s[3 * 33]); o.z = pk2(s[4 * 33], s[5 * 33]); o.w = pk2(s[6 * 33], s[7 * 33]);
        *(u32x4*)(WT + (size_t)wrow<MODE>(n0 + n) * K + k0 + 8 * c) = o; }
    asm volatile("s_waitcnt lgkmcnt(0)" ::: "memory");
}

__device__ __forceinline__ void row_load(const float* p, int lane, f32x4 (&v)[4]) {
#pragma unroll
    for (int j = 0; j < 4; ++j) v[j] = *(const f32x4*)(p + 256 * j + 4 * lane);
}
__device__ __forceinline__ void row_stats(const f32x4 (&v)[4], float& mean, float& rstd) {
    float s = 0.f;
#pragma unroll
    for (int j = 0; j < 4; ++j) s += (v[j].x + v[j].y) + (v[j].z + v[j].w);
    mean = wave_sum(s) * (1.f / DM); float s2 = 0.f;
#pragma unroll
    for (int j = 0; j < 4; ++j) { const f32x4 d = v[j] - mean; s2 += (d.x * d.x + d.y * d.y) + (d.z * d.z + d.w * d.w); }
    rstd = 1.f / sqrtf(wave_sum(s2) * (1.f / DM) + LN_EPS);
}
__device__ __forceinline__ void row_store_bf16(bf16_t* p, int lane, const f32x4 (&v)[4]) {
#pragma unroll
    for (int j = 0; j < 4; ++j) { u32x2 w; w.x = pk2(v[j].x, v[j].y); w.y = pk2(v[j].z, v[j].w); *(u32x2*)(p + 256 * j + 4 * lane) = w; }
}

__device__ __forceinline__ int crow(int r, int hi) { return (r & 3) + 8 * (r >> 2) + 4 * hi; }

__device__ __forceinline__ void attn_phase(LAS unsigned char* lds, const bf16_t* __restrict__ QK, const bf16_t* __restrict__ VT, bf16_t* __restrict__ O,
                                           unsigned* ctr, const float* __restrict__ subln_g, const float* lamp) {
    const unsigned* kmax2 = ctr + 16;
    const int tid = threadIdx.x, lane = tid & 63, wid = __builtin_amdgcn_readfirstlane(tid >> 6), r32 = lane & 31, hi = lane >> 5;
    const int sub = wid >> 2, qw = wid & 3;
    LAS unsigned* uslot = (LAS unsigned*)(lds + 98304);
    const float lam = *lamp;
    int kog[2], vog[2]; unsigned kld[2], vld[2];
#pragma unroll
    for (int i = 0; i < 2; ++i) {
        const int p = wid * 2 + i;
        const int kv = 4 * p + (lane >> 4), cc = (lane & 15) ^ (kv & 15);
        kog[i] = kv * 2048 + cc * 8; kld[i] = (unsigned)p * 1024u;
        const int d = 8 * p + (lane >> 3), j = (lane & 7) ^ ((d >> 1) & 7);
        vog[i] = d * 4096 + j * 8; vld[i] = 16384u + (unsigned)p * 1024u;
    }
    int kaddr[4], vaddr[4];
    { const int kb = (sub * 8 + hi) ^ (r32 & 15), vb = hi ^ ((r32 >> 1) & 7);
#pragma unroll
      for (int q = 0; q < 4; ++q) { kaddr[q] = r32 * 256 + ((kb ^ (2 * q)) * 16); vaddr[q] = 16384 + r32 * 128 + ((vb ^ (2 * q)) * 16); } }
#define ATT_DMA(t_, st_) do { _Pragma("unroll") for (int i_ = 0; i_ < 2; ++i_) { \
        __builtin_amdgcn_global_load_lds((const unsigned*)(Kg + (size_t)(t_) * 64 * 2048 + kog[i_]), (LAS unsigned*)(lds + (st_) + kld[i_]), 16, 0, 0); \
        __builtin_amdgcn_global_load_lds((const unsigned*)(Vg + (t_) * 64 + vog[i_]), (LAS unsigned*)(lds + (st_) + vld[i_]), 16, 0, 0); } } while (0)
    for (;;) {
        __syncthreads();
        if (tid == 0) *uslot = atomicAdd(ctr, 1u);
        __syncthreads();
        const unsigned un = *uslot;
        if (un >= 1024u) break;
        const int h = 7 - (int)(un >> 7), rr = (int)(un & 127u), b = rr >> 5, qb = rr & 31;
        const float slope2 = __builtin_amdgcn_exp2f(-(float)(h + 1)) * LOG2E;
        const int qpos = qb * 128 + qw * 32 + r32;
        const bf16_t* Qrow = QK + (size_t)(b * SEQ + qpos) * 2048 + h * 128 + sub * 64;
        const bf16_t* Kg = QK + (size_t)b * SEQ * 2048 + 1024 + h * 128;
        const bf16_t* Vg = VT + ((size_t)(b * 1024 + h * 128)) * 4096;
        bf16x8 qr[4];
#pragma unroll
        for (int d0 = 0; d0 < 4; ++d0) qr[d0] = *(const bf16x8*)(Qrow + d0 * 16 + hi * 8);
        float mhat; int tlo, thi;
        { float sd = 0.f, qn = 0.f;
#pragma unroll
          for (int d0 = 0; d0 < 4; ++d0) { const bf16x8 kd = *(const bf16x8*)(Qrow + 1024 + d0 * 16 + hi * 8);
#pragma unroll
              for (int e = 0; e < 8; ++e) { const float qv = bf2f(qr[d0][e]); sd += qv * bf2f(kd[e]); qn += qv * qv; } }
          mhat = half_swap_sum(sd); qn = half_swap_sum(qn);
          const unsigned* kp = kmax2 + ((b * 8 + h) * 2 + sub) * 2;
          const float km2 = (__uint_as_float(kp[0]) + __uint_as_float(kp[1])) * 1.02f;
          float wb = sqrtf(qn * km2) * 1.01f + 0.5f - mhat;
#pragma unroll
          for (int o_ = 1; o_ < 64; o_ <<= 1) wb = fmaxf(wb, __shfl_xor(wb, o_));
          LAS float* wmx = (LAS float*)(lds + 98304 + 64);
          if (lane == 0) wmx[wid] = wb;
          __syncthreads();
          float bm = wmx[0];
#pragma unroll
          for (int w_ = 1; w_ < 8; ++w_) bm = fmaxf(bm, wmx[w_]);
          const float dmax = (140.f + bm) / slope2;
          const float flo = ((float)(qb * 128) - dmax) * (1.f / 64.f), fhi = ((float)(qb * 128 + 127) + dmax) * (1.f / 64.f);
          tlo = flo <= 0.f ? 0 : (int)flo; thi = fhi >= 63.f ? 63 : (int)fhi;
          if (!(bm == bm)) { tlo = 0; thi = 63; }
        }
        ATT_DMA(tlo, 0); if (tlo + 1 <= thi) ATT_DMA(tlo + 1, 32768);
        f32x16 o[4];
#pragma unroll
        for (int db = 0; db < 4; ++db)
#pragma unroll
            for (int r = 0; r < 16; ++r) o[db][r] = 0.f;
        float l_reg = 0.f;
        asm volatile("s_waitcnt vmcnt(0)\n\ts_barrier" ::: "memory");
        int st = 0, st2 = 65536;
        float crs[16];
#pragma unroll
        for (int r = 0; r < 16; ++r) crs[r] = slope2 * (float)((r & 3) + 8 * (r >> 2));
        const int qlo = qb * 128 + qw * 32;
        for (int t = tlo; t <= thi; ++t) {
            if (t + 2 <= thi) ATT_DMA(t + 2, st2);
            {
                const LAS unsigned char* Sb = lds + st;
                bf16x8 kf[8];
#pragma unroll
                for (int d0 = 0; d0 < 4; ++d0) { kf[2 * d0] = *(const LAS bf16x8*)(Sb + kaddr[d0]); kf[2 * d0 + 1] = *(const LAS bf16x8*)(Sb + kaddr[d0] + 8192); }
                __builtin_amdgcn_sched_barrier(0);
                const int kv0 = t * 64;
                const float dq = (float)(qpos - kv0 - 4 * hi);
                f32x16 p0, p1;
                if (kv0 + 63 < qlo || kv0 > qlo + 31) {
                    const float sg = (kv0 + 63 < qlo) ? 1.f : -1.f;
                    const float b0 = -sg * slope2 * dq - mhat, b1 = b0 + sg * slope2 * 32.f;
#pragma unroll
                    for (int r = 0; r < 16; ++r) { p0[r] = __builtin_fmaf(sg, crs[r], b0); p1[r] = __builtin_fmaf(sg, crs[r], b1); }
                } else {
#pragma unroll
                    for (int r = 0; r < 16; ++r) { const float cr = (float)((r & 3) + 8 * (r >> 2));
                        p0[r] = __builtin_fmaf(-slope2, __builtin_fabsf(dq - cr), -mhat); p1[r] = __builtin_fmaf(-slope2, __builtin_fabsf(dq - cr - 32.f), -mhat); }
                }
                __builtin_amdgcn_sched_barrier(0);
#pragma unroll
                for (int d0 = 0; d0 < 4; ++d0) {
                    p0 = __builtin_amdgcn_mfma_f32_32x32x16_bf16(kf[2 * d0], qr[d0], p0, 0, 0, 0);
                    p1 = __builtin_amdgcn_mfma_f32_32x32x16_bf16(kf[2 * d0 + 1], qr[d0], p1, 0, 0, 0);
                }
                bf16x8 vf[8];
#pragma unroll
                for (int g = 0; g < 4; ++g) { vf[g] = *(const LAS bf16x8*)(Sb + vaddr[g]); vf[4 + g] = *(const LAS bf16x8*)(Sb + vaddr[g] + 4096); }
                asm volatile("s_nop 15\n\ts_nop 7" : "+v"(p0), "+v"(p1));
                float rm, rm2;
                rm = max3f(p0[0], p0[1], p1[0]); rm2 = max3f(p0[2], p0[3], p1[1]); rm = max3f(rm, p1[2], p1[3]);
#pragma unroll
                for (int r = 4; r < 16; r += 4) { rm = max3f(rm, p0[r], p0[r + 1]); rm2 = max3f(rm2, p0[r + 2], p0[r + 3]); rm = max3f(rm, p1[r], p1[r + 1]); rm2 = max3f(rm2, p1[r + 2], p1[r + 3]); }
                rm = half_swap_max(fmaxf(rm, rm2));
                if (__any(rm > 8.f)) {
                    const float dl = fmaxf(rm, 0.f); mhat += dl;
                    const float f = __builtin_amdgcn_exp2f(-dl); l_reg *= f;
#pragma unroll
                    for (int r = 0; r < 16; ++r) { p0[r] -= dl; p1[r] -= dl; }
#pragma unroll
                    for (int db = 0; db < 4; ++db)
#pragma unroll
                        for (int r = 0; r < 16; ++r) o[db][r] *= f;
                    rm -= dl;
                }
                if (!__all(rm < -140.f)) {
                    float sacc = 0.f, sacc2 = 0.f;
#pragma unroll
                    for (int r = 0; r < 16; ++r) { p0[r] = __builtin_amdgcn_exp2f(p0[r]); p1[r] = __builtin_amdgcn_exp2f(p1[r]); sacc += p0[r]; sacc2 += p1[r]; }
                    l_reg += sacc + sacc2;
                    u32x4 w0, w1, w2, w3;
                    w0.x = cvt_pk_bf16(p0[0], p0[1]); w0.y = cvt_pk_bf16(p0[2], p0[3]); w0.z = cvt_pk_bf16(p0[4], p0[5]); w0.w = cvt_pk_bf16(p0[6], p0[7]);
                    w1.x = cvt_pk_bf16(p0[8], p0[9]); w1.y = cvt_pk_bf16(p0[10], p0[11]); w1.z = cvt_pk_bf16(p0[12], p0[13]); w1.w = cvt_pk_bf16(p0[14], p0[15]);
                    w2.x = cvt_pk_bf16(p1[0], p1[1]); w2.y = cvt_pk_bf16(p1[2], p1[3]); w2.z = cvt_pk_bf16(p1[4], p1[5]); w2.w = cvt_pk_bf16(p1[6], p1[7]);
                    w3.x = cvt_pk_bf16(p1[8], p1[9]); w3.y = cvt_pk_bf16(p1[10], p1[11]); w3.z = cvt_pk_bf16(p1[12], p1[13]); w3.w = cvt_pk_bf16(p1[14], p1[15]);
                    const bf16x8 pb0 = __builtin_bit_cast(bf16x8, w0), pb1 = __builtin_bit_cast(bf16x8, w1), pb2 = __builtin_bit_cast(bf16x8, w2), pb3 = __builtin_bit_cast(bf16x8, w3);
                    __builtin_amdgcn_sched_barrier(0);
                    bf16x8 vg[8];
#pragma unroll
                    for (int g = 0; g < 4; ++g) { vg[g] = *(const LAS bf16x8*)(Sb + vaddr[g] + 8192); vg[4 + g] = *(const LAS bf16x8*)(Sb + vaddr[g] + 12288); }
                    o[0] = __builtin_amdgcn_mfma_f32_32x32x16_bf16(vf[0], pb0, o[0], 0, 0, 0); o[1] = __builtin_amdgcn_mfma_f32_32x32x16_bf16(vf[4], pb0, o[1], 0, 0, 0);
                    o[0] = __builtin_amdgcn_mfma_f32_32x32x16_bf16(vf[1], pb1, o[0], 0, 0, 0); o[1] = __builtin_amdgcn_mfma_f32_32x32x16_bf16(vf[5], pb1, o[1], 0, 0, 0);
                    o[0] = __builtin_amdgcn_mfma_f32_32x32x16_bf16(vf[2], pb2, o[0], 0, 0, 0); o[1] = __builtin_amdgcn_mfma_f32_32x32x16_bf16(vf[6], pb2, o[1], 0, 0, 0);
                    o[0] = __builtin_amdgcn_mfma_f32_32x32x16_bf16(vf[3], pb3, o[0], 0, 0, 0); o[1] = __builtin_amdgcn_mfma_f32_32x32x16_bf16(vf[7], pb3, o[1], 0, 0, 0);
                    __builtin_amdgcn_sched_barrier(0);
                    o[2] = __builtin_amdgcn_mfma_f32_32x32x16_bf16(vg[0], pb0, o[2], 0, 0, 0); o[3] = __builtin_amdgcn_mfma_f32_32x32x16_bf16(vg[4], pb0, o[3], 0, 0, 0);
                    o[2] = __builtin_amdgcn_mfma_f32_32x32x16_bf16(vg[1], pb1, o[2], 0, 0, 0); o[3] = __builtin_amdgcn_mfma_f32_32x32x16_bf16(vg[5], pb1, o[3], 0, 0, 0);
                    o[2] = __builtin_amdgcn_mfma_f32_32x32x16_bf16(vg[2], pb2, o[2], 0, 0, 0); o[3] = __builtin_amdgcn_mfma_f32_32x32x16_bf16(vg[6], pb2, o[3], 0, 0, 0);
                    o[2] = __builtin_amdgcn_mfma_f32_32x32x16_bf16(vg[3], pb3, o[2], 0, 0, 0); o[3] = __builtin_amdgcn_mfma_f32_32x32x16_bf16(vg[7], pb3, o[3], 0, 0, 0);
                }
            }
            if (t + 2 <= thi) asm volatile("s_waitcnt vmcnt(4) lgkmcnt(0)\n\ts_barrier" ::: "memory");
            else asm volatile("s_waitcnt vmcnt(0) lgkmcnt(0)\n\ts_barrier" ::: "memory");
            st2 = st; st = (st == 65536) ? 0 : st + 32768;
        }
        const float inv = 1.f / half_swap_sum(l_reg);
        LAS float* XO = (LAS float*)lds;
        if (sub == 1) {
#pragma unroll
            for (int db = 0; db < 4; ++db)
#pragma unroll
                for (int r = 0; r < 16; ++r) XO[((qw * 64 + db * 16 + r) * 64) + lane] = o[db][r] * inv;
        }
        __syncthreads();
        if (sub == 0) {
            float ss = 0.f;
#pragma unroll
            for (int db = 0; db < 4; ++db)
#pragma unroll
                for (int r = 0; r < 16; ++r) { const float v = o[db][r] * inv - lam * XO[((qw * 64 + db * 16 + r) * 64) + lane]; o[db][r] = v; ss += v * v; }
            ss = half_swap_sum(ss);
            const float rs = (1.f / sqrtf(ss * (1.f / 128.f) + LN_EPS)) * (1.f - LAM_INIT);
            bf16_t* Orow = O + (size_t)(b * SEQ + qpos) * DM + h * 128;
#pragma unroll
            for (int db = 0; db < 4; ++db)
#pragma unroll
                for (int rq = 0; rq < 4; ++rq) {
                    const int d = db * 32 + 8 * rq + 4 * hi;
                    const f32x4 gv = *(const f32x4*)(subln_g + d);
                    u32x2 w; w.x = cvt_pk_bf16(o[db][4 * rq + 0] * rs * gv.x, o[db][4 * rq + 1] * rs * gv.y); w.y = cvt_pk_bf16(o[db][4 * rq + 2] * rs * gv.z, o[db][4 * rq + 3] * rs * gv.w);
                    *(u32x2*)(Orow + d) = w;
                }
        }
    }
}

#define XB_TMO      128
#define XB_XCNT(j)  (256  + 64 * (j))
#define XB_XSUB(j)  (1280 + 64 * (j))
#define XB_XGEN(j)  (2304 + 64 * (j))
#define XB_TOP      3328
#define XB_TOPGEN   3392
#define XCD_BAR_WORDS 3456
#define XB_SPIN_CAP (1u << 18)
__device__ __forceinline__ unsigned xb_ld(unsigned* p)              { return __hip_atomic_load(p, __ATOMIC_RELAXED, __HIP_MEMORY_SCOPE_AGENT); }
__device__ __forceinline__ unsigned xb_add(unsigned* p, unsigned v) { return __hip_atomic_fetch_add(p, v, __ATOMIC_RELAXED, __HIP_MEMORY_SCOPE_AGENT); }
__device__ __forceinline__ unsigned xb_xcc_id() { return (unsigned)__builtin_amdgcn_s_getreg((3 << 11) | 20) & 0xFu; }
#define XB_SPIN(cond, bar) do { unsigned _sp = 0; while (cond) { __builtin_amdgcn_s_sleep(1); \
    if ((++_sp & 255u) == 0u) { if (xb_ld(&(bar)[XB_TMO])) break; if (_sp > XB_SPIN_CAP) { atomicAdd(&(bar)[XB_TMO], 1u); break; } } } } while (0)
struct XcdBarrier { unsigned* bar; unsigned x; volatile LAS unsigned* st; };
__device__ __forceinline__ XcdBarrier xcd_barrier_post(unsigned* bar, volatile LAS unsigned* st) {
    XcdBarrier b; b.bar = bar; b.x = xb_xcc_id(); b.st = st;
    if (threadIdx.x == 0) (void)xb_add(&bar[XB_XCNT(b.x)], 1u);
    return b;
}
__device__ __forceinline__ void xcd_barrier_complete(unsigned* bar, unsigned x, unsigned& nloc, unsigned& nx) {
    const unsigned G = gridDim.x * gridDim.y * gridDim.z;
    unsigned sum, cnt, mine, sp = 0u;
    for (;;) {
        sum = 0u; cnt = 0u; mine = 0u;
#pragma unroll
        for (unsigned j = 0; j < 16; ++j) { const unsigned c = xb_ld(&bar[XB_XCNT(j)]); sum += c; cnt += (c > 0u) ? 1u : 0u; mine = (j == x) ? c : mine; }
        if (sum == G) break;
        __builtin_amdgcn_s_sleep(1);
        if ((++sp & 255u) == 0u) { if (xb_ld(&bar[XB_TMO])) break; if (sp > XB_SPIN_CAP) { atomicAdd(&bar[XB_TMO], 1u); break; } }
    }
    nloc = mine > 0u ? mine : 1u; nx = cnt > 0u ? cnt : 1u;
}
__device__ __forceinline__ void xcd_barrier(const XcdBarrier& b) {
    asm volatile("s_waitcnt vmcnt(0)" ::: "memory");
    __syncthreads();
    if (threadIdx.x == 0) {
        unsigned* bar = b.bar;
        __builtin_amdgcn_s_waitcnt(0);
        unsigned nloc = b.st[0], nx = b.st[1];
        if (nloc == 0u) { xcd_barrier_complete(bar, b.x, nloc, nx); b.st[0] = nloc; b.st[1] = nx; }
        const unsigned old = xb_add(&bar[XB_XSUB(b.x)], 1u);
        const unsigned gen = old / nloc;
        if (old + 1u == (gen + 1u) * nloc) {
            __builtin_amdgcn_fence(__ATOMIC_RELEASE, "agent");
            asm volatile("s_waitcnt vmcnt(0)" ::: "memory");
            const unsigned og = xb_add(&bar[XB_TOP], 1u);
            const unsigned tg = og / nx;
            if (og + 1u == (tg + 1u) * nx) xb_add(&bar[XB_TOPGEN], 1u);
            else XB_SPIN(xb_ld(&bar[XB_TOPGEN]) == tg, bar);
            __builtin_amdgcn_fence(__ATOMIC_ACQUIRE, "agent");
            xb_add(&bar[XB_XGEN(b.x)], 1u);
            asm volatile("s_waitcnt vmcnt(0)" ::: "memory");
        } else {
            XB_SPIN(xb_ld(&bar[XB_XGEN(b.x)]) == gen, bar);
            __builtin_amdgcn_fence(__ATOMIC_ACQUIRE, "agent");
            asm volatile("s_waitcnt vmcnt(0)" ::: "memory");
        }
    }
    __syncthreads();
}

struct Args { const float* in[30]; float* out; unsigned char* ws; int ph_lo, ph_hi; };
constexpr int N_PHASES = 17;

__global__ void __launch_bounds__(512, 2) mk_fwd(Args a) {
    extern __shared__ __attribute__((aligned(16))) unsigned char lds_raw[];
    LAS unsigned char* lds = (LAS unsigned char*)lds_raw;
    cg::grid_group grid = cg::this_grid();
    const int tid = threadIdx.x, lane = tid & 63, wid = __builtin_amdgcn_readfirstlane(tid >> 6);
    const int G = gridDim.x, gw = blockIdx.x * 8 + wid, NGW = G * 8;
    const int lo = a.ph_lo, hi = a.ph_hi;
    unsigned char* ws = a.ws;
    float* modpart = (float*)(ws + WS_MODPART); float* mod = (float*)(ws + WS_MOD);
    unsigned* ctr = (unsigned*)(ws + WS_SCAL); float* lamp = (float*)(ws + WS_SCAL + 4);
    float* rstats = (float*)(ws + WS_STATS);
    float* uedge = (float*)(ws + WS_UEDGE); float* xt = (float*)(ws + WS_XT);
    bf16_t* hbuf = (bf16_t*)(ws + WS_H); bf16_t* Cs = (bf16_t*)(ws + WS_CS); bf16_t* Ut = (bf16_t*)(ws + WS_UT);
    bf16_t* act = (bf16_t*)(ws + WS_ACT); bf16_t* QKb = (bf16_t*)(ws + WS_QK); bf16_t* VTb = (bf16_t*)(ws + WS_VT);
    bf16_t* Wcs = (bf16_t*)(ws + WS_WCS); bf16_t* Wup0 = (bf16_t*)(ws + WS_UP0); bf16_t* Wdn0 = (bf16_t*)(ws + WS_DN0);
    bf16_t* Win = (bf16_t*)(ws + WS_WIN); bf16_t* Wo = (bf16_t*)(ws + WS_WO); bf16_t* Wup1 = (bf16_t*)(ws + WS_UP1); bf16_t* Wdn1 = (bf16_t*)(ws + WS_DN1);
#define IN(k) (lo <= (k) && (k) < hi)
#define SEAM(k) do { if (IN(k) && IN((k) + 1)) { xcd_barrier(xbar); } } while (0)
    { volatile LAS unsigned* st_ = (volatile LAS unsigned*)(lds + XCH_OFF + 8192); if (tid < 2) st_[tid] = 0u; }
    __syncthreads();
    if (a.ph_hi > 1000) grid.sync();
    XcdBarrier xbar = xcd_barrier_post((unsigned*)(ws + WS_BAR), (volatile LAS unsigned*)(lds + XCH_OFF + 8192));

    if (IN(0)) {
        LAS float* csilu = (LAS float*)lds;
        LAS float* wtile = (LAS float*)(lds + 16384);
        LAS float* scr = (LAS float*)(lds + 34816) + wid * 2112;
        const float* cvec = a.in[1];
        for (int i = tid; i < 4096; i += 512) { const float cv = cvec[i]; csilu[i] = cv / (1.f + __expf(-cv)); }
        __syncthreads();
        for (int it = gw; it < 1536; it += NGW) {
            const int l = it / 768, r = it % 768, nch = r >> 3, kc = r & 7;
            const float* W = (l ? a.in[13] : a.in[2]) + (size_t)(kc * 128) * 6144 + nch * 64 + lane;
            float a0 = 0.f, a1 = 0.f, a2 = 0.f, a3 = 0.f;
#pragma unroll 16
            for (int k = 0; k < 128; ++k) { const float w = W[(size_t)k * 6144]; const int kk = kc * 128 + k;
                a0 += csilu[kk] * w; a1 += csilu[1024 + kk] * w; a2 += csilu[2048 + kk] * w; a3 += csilu[3072 + kk] * w; }
            float* mp = modpart + (size_t)((kc * 2 + l) * 4) * 6144 + nch * 64 + lane;
            mp[0] = a0; mp[6144] = a1; mp[2 * 6144] = a2; mp[3 * 6144] = a3;
        }
        for (int it = gw; it < 10496; it += NGW) {
            int r = it;
            if (r < 2816) { transpose_item<1>(a.in[7], DM, NUP, Wup0, scr, r, lane); continue; } r -= 2816;
            if (r < 1408) { transpose_item<0>(a.in[10], DFF, DM, Wdn0, scr, r, lane); continue; } r -= 1408;
            if (r < 1536) { transpose_item<0>(a.in[15], DM, 3072, Win, scr, r, lane); continue; } r -= 1536;
            if (r < 512) { transpose_item<0>(a.in[21], DM, DM, Wo, scr, r, lane); continue; } r -= 512;
            if (r < 2816) { transpose_item<1>(a.in[24], DM, NUP, Wup1, scr, r, lane); continue; } r -= 2816;
            transpose_item<0>(a.in[27], DFF, DM, Wdn1, scr, r, lane);
        }
        for (int it = blockIdx.x; it < 256; it += G) {
            const int g = it >> 5, cb = it & 31, j = tid & 127, cgp = tid >> 7;
            __syncthreads();
            { const int rr = tid >> 3, c4 = (tid & 7) * 4;
#pragma unroll
              for (int q = 0; q < 2; ++q) *(LAS f32x4*)(wtile + (rr + 64 * q) * 32 + c4) = *(const f32x4*)(a.in[4] + (size_t)(g * 128 + rr + 64 * q) * DM + cb * 32 + c4); }
            __syncthreads();
            float ac[8], as[8];
#pragma unroll
            for (int e = 0; e < 8; ++e) { ac[e] = 0.f; as[e] = 0.f; }
#pragma unroll 4
            for (int mp = 0; mp < 128; ++mp) { const float ang = (float)((mp * j) & 127) * (1.f / 128.f); const float cv = __builtin_amdgcn_cosf(ang), sv = __builtin_amdgcn_sinf(ang);
                const f32x4 w0 = *(const LAS f32x4*)(wtile + mp * 32 + cgp * 8), w1 = *(const LAS f32x4*)(wtile + mp * 32 + cgp * 8 + 4);
#pragma unroll
                for (int e = 0; e < 4; ++e) { ac[e] += cv * w0[e]; as[e] += sv * w0[e]; ac[4 + e] += cv * w1[e]; as[4 + e] += sv * w1[e]; } }
            const float inv = 0.08838834764831845f; const int c0 = cb * 32 + cgp * 8;
#pragma unroll
            for (int e = 0; e < 8; ++e) { Wcs[(size_t)(c0 + e) * DM + g * 128 + j] = (bf16_t)f2bf(ac[e] * inv); Wcs[(size_t)(1024 + c0 + e) * DM + g * 128 + j] = (bf16_t)f2bf(as[e] * inv); }
        }
        for (int it = blockIdx.x * 512 + tid; it < 2097152; it += G * 512) {
            const int k = it >> 9, kk0 = (it & 511) * 8; float v[8];
#pragma unroll
            for (int e = 0; e < 8; ++e) { const int kk = kk0 + e; const int idx = (kk <= 2048) ? ((k * kk) & 4095) : ((k * (kk - 2048) + 1024) & 4095);
                v[e] = __builtin_amdgcn_cosf((float)idx * (1.f / 4096.f)) * (1.f / 64.f); }
            u32x4 w; w.x = pk2(v[0], v[1]); w.y = pk2(v[2], v[3]); w.z = pk2(v[4], v[5]); w.w = pk2(v[6], v[7]);
            *(u32x4*)(Cs + (size_t)k * 4096 + kk0) = w;
        }
        if (blockIdx.x == 0 && wid == 0) {
            const float p1 = wave_sum(a.in[16][lane] * a.in[17][lane]), p2 = wave_sum(a.in[18][lane] * a.in[19][lane]);
            if (lane == 0) { *lamp = expf(p1) - expf(p2) + LAM_INIT; *ctr = 0u; }
            ctr[16 + lane] = 0u; ctr[16 + 64 + lane] = 0u;
        }
    }
    SEAM(0);
    if (IN(1)) {
        LAS float* lmod = (LAS float*)lds;
        for (int idx = tid; idx < 8192; idx += 512) { const int b = idx >> 11, w = (idx >> 10) & 1, col = idx & 1023, n = w * 1024 + col; float s = a.in[3][n];
            for (int kc = 0; kc < 8; ++kc) s += modpart[(size_t)((kc * 2 + 0) * 4 + b) * 6144 + n];
            lmod[idx] = s; }
        for (int idx = blockIdx.x * 512 + tid; idx < 49152; idx += G * 512) { const int l = idx / 24576, r = idx % 24576, b = r / 6144, n = r % 6144; float s = (l ? a.in[14] : a.in[3])[n];
            for (int kc = 0; kc < 8; ++kc) s += modpart[(size_t)((kc * 2 + l) * 4 + b) * 6144 + n];
            mod[idx] = s; }
        __syncthreads();
        const float* x = a.in[0];
        for (int p = gw; p < NB * 2049; p += NGW) {
            const int b = p / 2049, n = p % 2049;
            f32x4 v[4], sh[4], sc[4]; float mean, rstd;
#pragma unroll
            for (int j = 0; j < 4; ++j) { sh[j] = *(const LAS f32x4*)(lmod + b * 2048 + 256 * j + 4 * lane); sc[j] = *(const LAS f32x4*)(lmod + b * 2048 + 1024 + 256 * j + 4 * lane); }
            row_load(x + (size_t)(b * SEQ + n) * DM, lane, v); row_stats(v, mean, rstd);
#pragma unroll
            for (int j = 0; j < 4; ++j) v[j] = (v[j] - mean) * rstd * (sc[j] + 1.f) + sh[j];
            if (n == 0 || n == 2048) { row_store_bf16(hbuf + (size_t)(b * SEQ + n) * DM, lane, v); }
            else {
                f32x4 v2[4]; row_load(x + (size_t)(b * SEQ + SEQ - n) * DM, lane, v2); row_stats(v2, mean, rstd);
#pragma unroll
                for (int j = 0; j < 4; ++j) { v2[j] = (v2[j] - mean) * rstd * (sc[j] + 1.f) + sh[j]; const f32x4 s = v[j] + v2[j], d = v[j] - v2[j]; v[j] = s; v2[j] = d; }
                row_store_bf16(hbuf + (size_t)(b * SEQ + n) * DM, lane, v); row_store_bf16(hbuf + (size_t)(b * SEQ + 2048 + n) * DM, lane, v2);
            }
        }
    }
    SEAM(1);
    if (IN(2)) {
        Gemm g{Wcs, hbuf, DM, DM, DM}; OrderU S{G, (int)blockIdx.x}; EpiUt E{Ut};
        gemm_phase<EpiUt, OrderU>(lds, g, S, E);
        for (int it = gw; it < 4096; it += NGW) { const int b = it >> 10, c = it & 1023;
            const bf16_t* hr = hbuf + (size_t)(b * SEQ + 2048) * DM + lane * 16; const bf16_t* wr_ = Wcs + (size_t)c * DM + lane * 16;
            const bf16x8 h0 = *(const bf16x8*)hr, h1 = *(const bf16x8*)(hr + 8), w0 = *(const bf16x8*)wr_, w1 = *(const bf16x8*)(wr_ + 8);
            float s = 0.f;
#pragma unroll
            for (int e = 0; e < 8; ++e) s += bf2f(h0[e]) * bf2f(w0[e]) + bf2f(h1[e]) * bf2f(w1[e]);
            s = wave_sum(s);
            if (lane == 0) Ut[(size_t)(b * 1024 + c) * 4096 + 2048] = (bf16_t)f2bf(s); }
    }
    SEAM(2);
    if (IN(3)) {
        Gemm g{Cs, Ut, 4096, 4096, 4096}; Order S; S.init(64, 4, G, (int)blockIdx.x, 1); EpiResid E{a.in[0], xt, mod + 0 * 24576 + 2 * 1024};
        gemm_phase<EpiResid, Order>(lds, g, S, E);
    }
    SEAM(3);
#define ROWPASS(LNG, LNB, MODL, KSH, KSC) do { \
        const float* lg_ = (LNG); const float* lb_ = (LNB); f32x4 gg[4], bb[4]; \
        _Pragma("unroll") for (int j = 0; j < 4; ++j) { gg[j] = *(const f32x4*)(lg_ + 256 * j + 4 * lane); bb[j] = *(const f32x4*)(lb_ + 256 * j + 4 * lane); } \
        for (int m0 = gw; m0 < MTOK; m0 += 4 * NGW) { f32x4 v[4][4]; float mean[4], rstd[4]; \
            _Pragma("unroll") for (int q = 0; q < 4; ++q) { const int m = m0 + q * NGW; if (m < MTOK) row_load(xt + (size_t)m * DM, lane, v[q]); } \
            _Pragma("unroll") for (int q = 0; q < 4; ++q) row_stats(v[q], mean[q], rstd[q]); \
            _Pragma("unroll") for (int q = 0; q < 4; ++q) { const int m = m0 + q * NGW; if (m < MTOK) { \
                if (lane == 0) *(f32x2*)(rstats + 2 * (size_t)m) = (f32x2){mean[q], rstd[q]}; \
                _Pragma("unroll") for (int j = 0; j < 4; ++j) v[q][j] = (v[q][j] - mean[q]) * rstd[q] * gg[j] + bb[j]; } } \
            _Pragma("unroll") for (int q = 0; q < 4; ++q) row_stats(v[q], mean[q], rstd[q]); \
            _Pragma("unroll") for (int q = 0; q < 4; ++q) { const int m = m0 + q * NGW; if (m < MTOK) { const float* mb_ = mod + (MODL) * 24576 + (m >> 12) * 6144; \
                _Pragma("unroll") for (int j = 0; j < 4; ++j) { const f32x4 sc = *(const f32x4*)(mb_ + (KSC) * 1024 + 256 * j + 4 * lane), sh = *(const f32x4*)(mb_ + (KSH) * 1024 + 256 * j + 4 * lane); \
                    v[q][j] = (v[q][j] - mean[q]) * rstd[q] * (sc + 1.f) + sh; } \
                row_store_bf16(hbuf + (size_t)m * DM, lane, v[q]); } } } } while (0)
#define FFN_UP(WUP, CW, CB) do { Gemm g{hbuf, (WUP), DM, DM, DM}; Order S; S.init(64, 22, G, (int)blockIdx.x, 0); \
        EpiFFN E{act, uedge, (CW), (CB), (LAS float*)(lds + XCH_OFF), lds + CWL_OFF}; gemm_phase<EpiFFN, Order>(lds, g, S, E); } while (0)
#define FFN_FIX(CW, CB) do { const float* cw_ = (CW); const float* cb_ = (CB); \
        for (int it = blockIdx.x * 512 + tid; it < 60 * DFF; it += G * 512) { const int bd = it / DFF, ch = it % DFF, pm = (bd / 15) * 16 + (bd % 15); \
            const int cv_ = (ch >> 7) * 256 + (ch & 127), cg_ = cv_ + 128; \
            const float* e0 = uedge + (size_t)(pm * 4) * NUP; const float* e1 = uedge + (size_t)((pm + 1) * 4) * NUP; \
            const float w0v = cw_[ch], w1v = cw_[NUP + ch], w2v = cw_[2 * NUP + ch], bv = cb_[ch]; \
            const float w0g = cw_[DFF + ch], w1g = cw_[NUP + DFF + ch], w2g = cw_[2 * NUP + DFF + ch], bg = cb_[DFF + ch]; \
            const float a254v = e0[2 * NUP + cv_], a255v = e0[3 * NUP + cv_], b0v = e1[cv_], b1v = e1[NUP + cv_]; \
            const float a254g = e0[2 * NUP + cg_], a255g = e0[3 * NUP + cg_], b0g = e1[cg_], b1g = e1[NUP + cg_]; \
            const float vA = w0v * a254v + w1v * a255v + w2v * b0v + bv, gA = w0g * a254g + w1g * a255g + w2g * b0g + bg; \
            const float vB = w0v * a255v + w1v * b0v + w2v * b1v + bv, gB = w0g * a255g + w1g * b0g + w2g * b1g + bg; \
            const size_t rA = (size_t)(pm * 256 + 255); \
            act[rA * DFF + ch] = (bf16_t)f2bf(gelu1(gA) * vA); act[(rA + 1) * DFF + ch] = (bf16_t)f2bf(gelu1(gB) * vB); } } while (0)
#define FFN_DOWN(WDN, MODL, LNG, LNB) do { Gemm g{act, (WDN), DFF, DFF, DFF}; Order S; S.init(64, 4, G, (int)blockIdx.x, 0); \
        EpiResidLN E{xt, xt, mod + (MODL) * 24576 + 5 * 1024, rstats, (LNG), (LNB)}; gemm_phase<EpiResidLN, Order>(lds, g, S, E); } while (0)

    if (IN(4)) ROWPASS(a.in[5], a.in[6], 0, 3, 4);
    SEAM(4);
    if (IN(5)) FFN_UP(Wup0, a.in[8], a.in[9]);
    SEAM(5);
    if (IN(6)) FFN_FIX(a.in[8], a.in[9]);
    SEAM(6);
    if (IN(7)) FFN_DOWN(Wdn0, 0, a.in[5], a.in[6]);
    SEAM(7);
    if (IN(8)) ROWPASS(a.in[11], a.in[12], 1, 0, 1);
    SEAM(8);
    if (IN(9)) {
        { Gemm g{hbuf, Win, DM, DM, DM}; Order S; S.init(64, 8, G, (int)blockIdx.x, 0); EpiQK E{QKb, ctr + 16}; gemm_phase<EpiQK, Order>(lds, g, S, E); }
        { Gemm g{Win, hbuf, DM, DM, DM}; Order S; S.init(4, 64, G, (int)blockIdx.x, 2); EpiVT E{VTb}; gemm_phase<EpiVT, Order>(lds, g, S, E); }
    }
    SEAM(9);
    if (IN(10)) attn_phase(lds, QKb, VTb, hbuf, ctr, a.in[20], lamp);
    SEAM(10);
    if (IN(11)) { Gemm g{hbuf, Wo, DM, DM, DM}; Order S; S.init(64, 4, G, (int)blockIdx.x, 0); EpiResidLN E{xt, xt, mod + 1 * 24576 + 2 * 1024, rstats, a.in[11], a.in[12]}; gemm_phase<EpiResidLN, Order>(lds, g, S, E); }
    SEAM(11);
    if (IN(12)) ROWPASS(a.in[22], a.in[23], 1, 3, 4);
    SEAM(12);
    if (IN(13)) FFN_UP(Wup1, a.in[25], a.in[26]);
    SEAM(13);
    if (IN(14)) FFN_FIX(a.in[25], a.in[26]);
    SEAM(14);
    if (IN(15)) FFN_DOWN(Wdn1, 1, a.in[22], a.in[23]);
    SEAM(15);
    if (IN(16)) {
        const float* lg_ = a.in[28]; const float* lb_ = a.in[29]; f32x4 gg[4], bb[4];
#pragma unroll
        for (int j = 0; j < 4; ++j) { gg[j] = *(const f32x4*)(lg_ + 256 * j + 4 * lane); bb[j] = *(const f32x4*)(lb_ + 256 * j + 4 * lane); }
        for (int m0 = gw; m0 < MTOK; m0 += 4 * NGW) { f32x4 v[4][4]; float mean[4], rstd[4];
#pragma unroll
            for (int q = 0; q < 4; ++q) { const int m = m0 + q * NGW; if (m < MTOK) row_load(xt + (size_t)m * DM, lane, v[q]); }
#pragma unroll
            for (int q = 0; q < 4; ++q) row_stats(v[q], mean[q], rstd[q]);
#pragma unroll
            for (int q = 0; q < 4; ++q) { const int m = m0 + q * NGW; if (m < MTOK) {
#pragma unroll
                for (int j = 0; j < 4; ++j) *(f32x4*)(a.out + (size_t)m * DM + 256 * j + 4 * lane) = (v[q][j] - mean[q]) * rstd[q] * gg[j] + bb[j]; } } }
    }
}

extern "C" void kernel_launch(void* const* d_in, const int* in_sizes, int n_in, void* d_out, int out_size, void* d_ws, size_t ws_size, hipStream_t stream) {
    static int grid = 0;
    if (grid == 0) {
        if (n_in != 30 || out_size != MTOK * DM || ws_size < WS_END) { fprintf(stderr, "kernel_launch: unexpected shapes (n_in %d, out %d, ws %zu)\n", n_in, out_size, ws_size); grid = -1; return; }
        int dev = 0, cus = 0, per_cu = 0;
        hipGetDevice(&dev); hipDeviceGetAttribute(&cus, hipDeviceAttributeMultiprocessorCount, dev);
        if (hipFuncSetAttribute((const void*)mk_fwd, hipFuncAttributeMaxDynamicSharedMemorySize, LDS_BYTES) != hipSuccess) { fprintf(stderr, "kernel_launch: hipFuncSetAttribute failed\n"); grid = -1; return; }
        if (hipOccupancyMaxActiveBlocksPerMultiprocessor(&per_cu, (const void*)mk_fwd, 512, LDS_BYTES) != hipSuccess || per_cu < 1) { fprintf(stderr, "kernel_launch: occupancy query says %d\n", per_cu); per_cu = 1; }
        (void)hipGetLastError();
        grid = cus * 1;
        if (grid <= 0) grid = 256;
    }
    if (grid < 0) return;
    Args a{};
    for (int i = 0; i < 30; ++i) a.in[i] = (const float*)d_in[i];
    a.out = (float*)d_out; a.ws = (unsigned char*)d_ws;
#if MK_ONE_LAUNCH
    if (hipMemsetAsync((char*)d_ws + WS_BAR, 0, 16384, stream) != hipSuccess) { fprintf(stderr, "kernel_launch: memset failed\n"); return; }
    a.ph_lo = 0; a.ph_hi = N_PHASES;
    void* args[] = {&a};
    hipError_t e = hipLaunchCooperativeKernel((const void*)mk_fwd, dim3(grid), dim3(512), args, LDS_BYTES, stream);
    if (e != hipSuccess) fprintf(stderr, "kernel_launch: cooperative launch failed: %s (grid %d)\n", hipGetErrorString(e), grid);
#else
    for (int p = 0; p < N_PHASES; ++p) {
        a.ph_lo = p; a.ph_hi = p + 1;
        hipLaunchKernelGGL(mk_fwd, dim3(grid), dim3(512), LDS_BYTES, stream, a);
    }
#endif
}
```
